# Optimizing an MI355X kernel written in HIP

```python
import math
import jax
import jax.numpy as jnp
from jax import lax
import numpy as np

D_MODEL = 2048
BATCH = 1
SEQ = 16384
DEPTH = 4

CHUNK = 64
Q_BLOCK = 128
N_MEM = 256
MAX_OFFSET = 4096
H_A = 4
DK_A = 64
DV_A = 2 * DK_A
H_B = 6
D_B = 128
FORGET_BIAS_CENTRE = 2.0
H_C = 6
Q_LORA = 512
KV_LORA = 256
D_NOPE = 64
D_ROPE = 32
DV_C = 128
ROPE_THETA = 10000.0
D_MIX = H_A * DV_A + H_B * D_B + H_C * DV_C
SPLIT_SIZES = (H_A * 2 * DK_A, H_A * 2 * DK_A, H_A * DV_A,
               H_B * D_B, H_B * D_B, H_B * D_B, H_B,
               Q_LORA, KV_LORA, D_ROPE)
D_IN = 2 * H_A * 2 * DK_A + H_A * DV_A + 3 * H_B * D_B + H_B + Q_LORA + KV_LORA + D_ROPE
N_BUCKETS = 32
MAX_DISTANCE = 512
H_X = 4
D_X = 128
D_FF = 4096
CONV_W = 3
EPS = 1e-6
NEG_INF = -1e30

kernel_name = "hymba_style_diff_fox_mla_streaming_trunk"


def _split_points():
    pts, acc = [], 0
    for s in SPLIT_SIZES[:-1]:
        acc += s
        pts.append(acc)
    return pts


def rms(x):
    xf = x.astype(jnp.float32)
    return (xf * lax.rsqrt(jnp.mean(xf * xf, axis=-1, keepdims=True) + EPS)).astype(x.dtype)


def rmsnorm(x, g):
    return rms(x) * g.astype(x.dtype)


def rope_angles(positions, dtype):
    inv = ROPE_THETA ** (-jnp.arange(0, D_ROPE, 2, dtype=jnp.float32) / D_ROPE)
    ang = positions.astype(jnp.float32)[..., None] * inv
    return jnp.cos(ang).astype(dtype), jnp.sin(ang).astype(dtype)


def apply_rope(t, cos, sin):
    t1, t2 = t[..., :D_ROPE // 2], t[..., D_ROPE // 2:]
    return jnp.concatenate([t1 * cos - t2 * sin, t2 * cos + t1 * sin], axis=-1)


def t5_bucket(rel):
    half = N_BUCKETS // 2
    max_exact = half // 2
    ret = jnp.where(rel > 0, half, 0)
    n = jnp.abs(rel)
    nf = jnp.maximum(n, 1).astype(jnp.float32)
    large = max_exact + (jnp.log(nf / max_exact) / math.log(MAX_DISTANCE / max_exact)
                         * (half - max_exact)).astype(jnp.int32)
    large = jnp.minimum(large, half - 1)
    return ret + jnp.where(n < max_exact, n, large)


def to_blocks(t):
    b, s = t.shape[0], t.shape[1]
    t = t.reshape((b, s // Q_BLOCK, Q_BLOCK) + t.shape[2:])
    return jnp.moveaxis(t, 1, 0)


def from_blocks(t):
    t = jnp.moveaxis(t, 0, 1)
    return t.reshape((t.shape[0], t.shape[1] * t.shape[2]) + t.shape[3:])


def hybrid_mixer(h, positions, rel_bias, w_in, b_forget, lam, lam_init,
                 q_norm, kv_norm, w_uq, w_ukv, head_norm, w_out):
    B, S, _ = h.shape
    f32 = jnp.float32
    qa, ka, va, qb, kb, vb, fb, cq, ckv, kr = jnp.split(h @ w_in, _split_points(), axis=-1)
    qa = qa.reshape(B, S, H_A, 2, DK_A)
    ka = ka.reshape(B, S, H_A, 2, DK_A)
    va = va.reshape(B, S, H_A, DV_A)
    lam = lam.astype(f32)
    lam_val = jnp.exp(jnp.sum(lam[0] * lam[1])) - jnp.exp(jnp.sum(lam[2] * lam[3])) + lam_init
    qb = qb.reshape(B, S, H_B, D_B)
    kb = kb.reshape(B, S, H_B, D_B)
    vb = vb.reshape(B, S, H_B, D_B)
    log_f = jax.nn.log_sigmoid(fb.astype(f32) + b_forget.astype(f32))
    cum_f = jnp.cumsum(log_f, axis=1)
    cum_f_k = jnp.transpose(cum_f, (0, 2, 1))
    cq = rmsnorm(cq, q_norm)
    ckv = rmsnorm(ckv, kv_norm)
    qc = (cq @ w_uq).reshape(B, S, H_C, D_NOPE + D_ROPE)
    kvc = (ckv @ w_ukv).reshape(B, S, H_C, D_NOPE + DV_C)
    qn, qr = qc[..., :D_NOPE], qc[..., D_NOPE:]
    kn, vc = kvc[..., :D_NOPE], kvc[..., D_NOPE:]
    cos, sin = rope_angles(positions, h.dtype)
    qr = apply_rope(qr, cos[:, :, None], sin[:, :, None])
    kr = apply_rope(kr, cos, sin)
    k_idx = jnp.arange(S)

    def attend_block(args):
        blk, qa_b, qb_b, fq_b, qn_b, qr_b, pq_b = args
        q_idx = blk * Q_BLOCK + jnp.arange(Q_BLOCK)
        chunk_ok = (k_idx[None, :] // CHUNK) <= (q_idx[:, None] // CHUNK)
        frame_ok = k_idx[None, :] <= q_idx[:, None]
        bucket = t5_bucket(positions[:, None, :] - pq_b[:, :, None])
        bias = jnp.moveaxis(rel_bias[bucket], -1, 1)[:, :, None].astype(f32)
        s_a = jnp.einsum('bqhmd,bkhmd->bhmqk', qa_b, ka).astype(f32) * DK_A ** -0.5 + bias
        p_a = jax.nn.softmax(jnp.where(chunk_ok, s_a, NEG_INF), axis=-1)
        p_a = p_a[:, :, 0] - lam_val * p_a[:, :, 1]
        o_a = jnp.einsum('bhqk,bkhd->bqhd', p_a.astype(va.dtype), va)
        s_b = (jnp.einsum('bqhd,bkhd->bhqk', qb_b, kb).astype(f32) * D_B ** -0.5
               + jnp.transpose(fq_b, (0, 2, 1))[..., None] - cum_f_k[:, :, None, :])
        p_b = jax.nn.softmax(jnp.where(frame_ok, s_b, NEG_INF), axis=-1)
        o_b = jnp.einsum('bhqk,bkhd->bqhd', p_b.astype(vb.dtype), vb)
        s_c = (jnp.einsum('bqhd,bkhd->bhqk', qn_b, kn)
               + jnp.einsum('bqhr,bkr->bhqk', qr_b, kr)).astype(f32) * (D_NOPE + D_ROPE) ** -0.5
        p_c = jax.nn.softmax(jnp.where(chunk_ok, s_c, NEG_INF), axis=-1)
        o_c = jnp.einsum('bhqk,bkhd->bqhd', p_c.astype(vc.dtype), vc)
        return o_a, o_b, o_c

    n_blk = S // Q_BLOCK
    o_a, o_b, o_c = lax.map(attend_block, (jnp.arange(n_blk), to_blocks(qa), to_blocks(qb),
                                           to_blocks(cum_f), to_blocks(qn), to_blocks(qr),
                                           to_blocks(positions)))
    o_a = rms(from_blocks(o_a)) * (1.0 - lam_init)
    o_b = rms(from_blocks(o_b))
    o_c = rms(from_blocks(o_c))
    o = jnp.concatenate([o_a.reshape(B, S, -1), o_b.reshape(B, S, -1), o_c.reshape(B, S, -1)],
                        axis=-1) * head_norm.astype(h.dtype)
    return o @ w_out


def memory_xattn(h, mem_n, wq, wkv, wo):
    B, S, _ = h.shape
    q = (h @ wq).reshape(B, S, H_X, D_X)
    k, v = jnp.split(mem_n @ wkv, 2, axis=-1)
    k = k.reshape(B, N_MEM, H_X, D_X)
    v = v.reshape(B, N_MEM, H_X, D_X)
    s = jnp.einsum('bqhd,bkhd->bhqk', q, k).astype(jnp.float32) * D_X ** -0.5
    p = jax.nn.softmax(s, axis=-1)
    o = jnp.einsum('bhqk,bkhd->bqhd', p.astype(v.dtype), v).reshape(B, S, H_X * D_X)
    return o @ wo


def conv_ffn(h, w_up, conv_w, conv_b, w_down):
    S = h.shape[1]
    u = h @ w_up
    up = jnp.pad(u, ((0, 0), (CONV_W - 1, 0), (0, 0)))
    c = conv_b.astype(h.dtype)
    for tap in range(CONV_W):
        c = c + up[:, tap:tap + S] * conv_w[tap]
    gate, val = jnp.split(c, 2, axis=-1)
    return (jax.nn.gelu(gate, approximate=True) * val) @ w_down


def setup_inputs(seed: int = 0) -> dict:
    key = jax.random.key(seed)
    ks = jax.random.split(key, 22)
    f32 = jnp.float32

    def nrm(k, shape, scale):
        return jax.random.normal(k, shape, f32) * scale

    def gain(k, shape):
        return 1.0 + 0.05 * jax.random.normal(k, shape, f32)

    x = nrm(ks[0], (BATCH, SEQ, D_MODEL), 1.0)
    mem = nrm(ks[1], (BATCH, N_MEM, D_MODEL), 1.0)
    offset = jax.random.randint(ks[2], (BATCH, 1), 0, MAX_OFFSET, dtype=jnp.int32)
    positions = offset + jnp.arange(SEQ, dtype=jnp.int32)[None, :]
    rel_bias = nrm(ks[3], (N_BUCKETS, H_A), 0.5)
    w_in = nrm(ks[4], (DEPTH, D_MODEL, D_IN), D_MODEL ** -0.5)
    b_forget = FORGET_BIAS_CENTRE + 0.5 * jax.random.normal(ks[5], (DEPTH, H_B), f32)
    lam = nrm(ks[6], (DEPTH, 4, DK_A), 0.1)
    q_norm = gain(ks[7], (DEPTH, Q_LORA))
    kv_norm = gain(ks[8], (DEPTH, KV_LORA))
    w_uq = nrm(ks[9], (DEPTH, Q_LORA, H_C * (D_NOPE + D_ROPE)), Q_LORA ** -0.5)
    w_ukv = nrm(ks[10], (DEPTH, KV_LORA, H_C * (D_NOPE + DV_C)), KV_LORA ** -0.5)
    head_norm = gain(ks[11], (DEPTH, D_MIX))
    w_out = nrm(ks[12], (DEPTH, D_MIX, D_MODEL), D_MIX ** -0.5)
    norm_gains = gain(ks[13], (DEPTH, 6, D_MODEL))
    mem_norm = gain(ks[14], (DEPTH, D_MODEL))
    wq_x = nrm(ks[15], (DEPTH, D_MODEL, H_X * D_X), D_MODEL ** -0.5)
    wkv_x = nrm(ks[16], (DEPTH, D_MODEL, 2 * H_X * D_X), D_MODEL ** -0.5)
    wo_x = nrm(ks[17], (DEPTH, H_X * D_X, D_MODEL), (H_X * D_X) ** -0.5)
    w_up = nrm(ks[18], (DEPTH, D_MODEL, 2 * D_FF), D_MODEL ** -0.5)
    conv_w = nrm(ks[19], (DEPTH, CONV_W, 2 * D_FF), CONV_W ** -0.5)
    conv_b = nrm(ks[20], (DEPTH, 2 * D_FF), 0.02)
    w_down = nrm(ks[21], (DEPTH, D_FF, D_MODEL), D_FF ** -0.5)
    return {"x": x, "mem": mem, "positions": positions, "rel_bias": rel_bias,
            "w_in": w_in, "b_forget": b_forget, "lam": lam, "q_norm": q_norm,
            "kv_norm": kv_norm, "w_uq": w_uq, "w_ukv": w_ukv, "head_norm": head_norm,
            "w_out": w_out, "norm_gains": norm_gains, "mem_norm": mem_norm,
            "wq_x": wq_x, "wkv_x": wkv_x, "wo_x": wo_x, "w_up": w_up,
            "conv_w": conv_w, "conv_b": conv_b, "w_down": w_down}


def reference(x, mem, positions, rel_bias, w_in, b_forget, lam, q_norm, kv_norm, w_uq, w_ukv,
              head_norm, w_out, norm_gains, mem_norm, wq_x, wkv_x, wo_x, w_up, conv_w, conv_b,
              w_down):
    for i in range(DEPTH):
        g = norm_gains[i]
        lam_init = 0.8 - 0.6 * math.exp(-0.3 * i)
        h = rmsnorm(x, g[0])
        y = hybrid_mixer(h, positions, rel_bias, w_in[i], b_forget[i], lam[i], lam_init,
                         q_norm[i], kv_norm[i], w_uq[i], w_ukv[i], head_norm[i], w_out[i])
        x = x + rmsnorm(y, g[1])
        mem_n = rmsnorm(mem, mem_norm[i])
        h = rmsnorm(x, g[2])
        x = x + rmsnorm(memory_xattn(h, mem_n, wq_x[i], wkv_x[i], wo_x[i]), g[3])
        h = rmsnorm(x, g[4])
        x = x + rmsnorm(conv_ffn(h, w_up[i], conv_w[i], conv_b[i], w_down[i]), g[5])
    return x
```

```cpp
#include <hip/hip_runtime.h>
#include <hip/hip_cooperative_groups.h>
#include <cstdio>
#include <cstdint>
namespace cg = cooperative_groups;
__device__ __forceinline__ int tid_opaque() { int t = threadIdx.x; asm volatile("" : "+v"(t)); return t; }
namespace pg8 {
#define PG8_LAS __attribute__((address_space(3)))
typedef unsigned short bf16_t;
typedef short bf16x8 __attribute__((ext_vector_type(8)));
typedef float f32x4 __attribute__((ext_vector_type(4)));
typedef unsigned u32x4 __attribute__((ext_vector_type(4)));
constexpr int BM = 256, BK = 64, HALF = 128, HTB = HALF * BK * 2  , STAGE_BYTES = 8 * HTB, NXCD = 8, WGM = 8;

__host__ __device__ __forceinline__ int lds_byte(int r, int c) { const int st = (r >> 4) * 2 + (c >> 5), rr = r & 15, cc = c & 31, ob = rr * 64 + cc * 2; return st * 1024 + (ob ^ (((ob >> 9) & 1) << 5)); }
__host__ __device__ __forceinline__ void stage_rc(int b, int& R, int& C) { const int st = b / 1024, sb = b % 1024, swz = sb ^ (((sb >> 9) & 1) << 5); R = (st >> 1) * 16 + swz / 64; C = (st & 1) * 32 + (swz % 64) / 2; }
__host__ __device__ __forceinline__ int perm32(int rho) { const int n = rho >> 4, i = rho & 15; return 8 * (i >> 2) + 4 * n + (i & 3); }

struct Unit { int pm, pn; };
struct Gemm { const bf16_t* A; const bf16_t* Bt; int M, N, K; };

struct StaticOrder {
    int nM, nN, nwg, G, c;
    __host__ __device__ void init(int M, int N, int G_, int c_) { nM = M / BM; nN = N / BM; nwg = nM * nN; G = G_; c = c_; }
    __host__ __device__ bool next(int i, Unit& u) const {
        const long L = (long)i * G + c; if (L >= nwg) return false;
        int wgid = (int)L; { const int q = nwg / NXCD, r = nwg % NXCD, xcd = wgid % NXCD, off = wgid / NXCD; wgid = (xcd < r ? xcd * (q + 1) : r * (q + 1) + (xcd - r) * q) + off; }
        const int nig = WGM * nN, gid = wgid / nig, fm = gid * WGM, gsz = (nM - fm) < WGM ? (nM - fm) : WGM;
        u.pm = fm + ((wgid % nig) % gsz); u.pn = (wgid % nig) / gsz; return true;
    }
    __device__ __forceinline__ void a_ready(const Unit&) const {}
    __device__ __forceinline__ void done(const Unit&) const {}
};

__device__ __forceinline__ unsigned cvt_pk_bf16(float lo, float hi) { unsigned r; asm volatile("v_cvt_pk_bf16_f32 %0, %1, %2" : "=v"(r) : "v"(lo), "v"(hi)); return r; }
typedef float f32x2 __attribute__((ext_vector_type(2)));
__device__ __forceinline__ f32x2 gelu_pk(f32x2 v) {
    const f32x2 av = __builtin_elementwise_abs(v), d = av * 0.2316418882f + 1.0f;
    f32x2 t; t.x = __builtin_amdgcn_rcpf(d.x); t.y = __builtin_amdgcn_rcpf(d.y);
    f32x2 q = t * 0.5307027145f + (-0.7265760135f); q = q * t + 0.7107068705f; q = q * t + (-0.142248368f); q = q * t + 0.127414796f; q = q * t;
    const f32x2 s = (v * v) * (-0.72134752044f);
    f32x2 e; e.x = __builtin_amdgcn_exp2f(s.x); e.y = __builtin_amdgcn_exp2f(s.y);
    const f32x2 m = v * (q * e), r = v - m;
    f32x2 o; o.x = v.x < 0.f ? m.x : r.x; o.y = v.y < 0.f ? m.y : r.y; return o;
}

template <int ACT  > struct EpiBf16 {
    static constexpr bool PERM = true, AFTER_DRAIN = false; static_assert(ACT == 0 || ACT == 1, "EpiBf16: ACT is 0 (none) or 1 (gelu_pk)");
    bf16_t* O; int ldc; const float* bias; int split_cols; size_t split_stride; float scale0;
    __device__ __forceinline__ void operator()(const f32x4 (&acc)[2][2][4][2], const Unit& u, int wr, int wc, int fr, int fq) const {
        const int row0 = u.pm * BM + wr * 64 + fr; int colt = u.pn * BM; bf16_t* base = O;
        float sc = 1.f; if (split_cols) { const int t = colt / split_cols; base += (size_t)t * split_stride; colt -= t * split_cols; if (t == 0) sc = scale0; }
        const int col0 = colt + wc * 32 + 8 * fq, bcol0 = u.pn * BM + wc * 32 + 8 * fq;
        f32x4 bv[2][2];
#pragma unroll
        for (int bj = 0; bj < 2; ++bj)
#pragma unroll
            for (int n = 0; n < 2; ++n) bv[bj][n] = bias ? *(const f32x4*)(bias + bcol0 + bj * HALF + 4 * n) : (f32x4){0.f, 0.f, 0.f, 0.f};
#pragma unroll
        for (int ai = 0; ai < 2; ++ai)
#pragma unroll
            for (int m = 0; m < 4; ++m) { bf16_t* rowp = base + (size_t)(row0 + ai * HALF + m * 16) * ldc + col0;
#pragma unroll
                for (int bj = 0; bj < 2; ++bj) { f32x4 v0 = acc[ai][bj][m][0] + bv[bj][0], v1 = acc[ai][bj][m][1] + bv[bj][1];
                    if (ACT == 1) { f32x2 a = gelu_pk((f32x2){v0[0], v0[1]}), b = gelu_pk((f32x2){v0[2], v0[3]}), c = gelu_pk((f32x2){v1[0], v1[1]}), d = gelu_pk((f32x2){v1[2], v1[3]});
                        v0 = (f32x4){a.x, a.y, b.x, b.y}; v1 = (f32x4){c.x, c.y, d.x, d.y}; }
                    v0 = v0 * sc; v1 = v1 * sc; u32x4 w; w.x = cvt_pk_bf16(v0[0], v0[1]); w.y = cvt_pk_bf16(v0[2], v0[3]); w.z = cvt_pk_bf16(v1[0], v1[1]); w.w = cvt_pk_bf16(v1[2], v1[3]);
                    *(u32x4*)(rowp + bj * HALF) = w; } }
    }
};


template <class Epi, class Sched, bool ALIGN_EPI = false, bool SP2 = false>
__device__ __forceinline__ void gemm_phase(PG8_LAS unsigned char* lds, const Gemm g, const Sched& S, const Epi& E) {
    const int tid = tid_opaque(), wid = __builtin_amdgcn_readfirstlane(tid >> 6), lane = tid & 63, wr = wid >> 2, wc = wid & 3, fr = lane & 15, fq = lane >> 4;
    const int K = g.K, nt = K / BK;
    unsigned voffA[2], voffB[2];
#pragma unroll
    for (int i = 0; i < 2; ++i) { int R, C; stage_rc(tid * 16 + i * 8192, R, C); const int Rb = Epi::PERM ? ((R & ~31) + perm32(R & 31)) : R;
        voffA[i] = (unsigned)(R * K + C) * 2u; voffB[i] = (unsigned)(Rb * K + C) * 2u; }
    const size_t kstep = (size_t)(BK * 2);
    const size_t hstep = (size_t)HALF * K * 2;
    const size_t tstep = 2 * hstep;
    const unsigned ldsw = (unsigned)wid * 1024u;
    const int aoff = lds_byte(wr * 64 + fr, fq * 8), boff = lds_byte(wc * 32 + fr, fq * 8);
#define PG8_SA(b, h) (((b) * 2 + (h)) * HTB)
#define PG8_SB(b, h) ((4 + (b) * 2 + (h)) * HTB)
#define PG8_STAGE(bufoff, gbase, voff) do { _Pragma("unroll") for (int _i = 0; _i < 2; ++_i) \
        __builtin_amdgcn_global_load_lds((const unsigned*)((const char*)(gbase) + (voff)[_i]), (PG8_LAS unsigned*)(lds + (bufoff) + ldsw + _i * 8192), 16, 0, 0); } while (0)
#define PG8_LDA(dst, b, h) do { _Pragma("unroll") for (int m = 0; m < 4; ++m) _Pragma("unroll") for (int k = 0; k < 2; ++k) dst[m][k] = *(const PG8_LAS bf16x8*)(lds + PG8_SA(b, h) + aoff + m * 2048 + k * 1024); } while (0)
#define PG8_LDB(dst, b, h) do { _Pragma("unroll") for (int n = 0; n < 2; ++n) _Pragma("unroll") for (int k = 0; k < 2; ++k) dst[n][k] = *(const PG8_LAS bf16x8*)(lds + PG8_SB(b, h) + boff + n * 2048 + k * 1024); } while (0)
#define PG8_MMA(ai, bj, At, Bt) do { __builtin_amdgcn_s_setprio(1); _Pragma("unroll") for (int m = 0; m < 4; ++m) _Pragma("unroll") for (int n = 0; n < 2; ++n) _Pragma("unroll") for (int k = 0; k < 2; ++k) \
        acc[ai][bj][m][n] = __builtin_amdgcn_mfma_f32_16x16x32_bf16(Bt[n][k], At[m][k], acc[ai][bj][m][n], 0, 0, 0); __builtin_amdgcn_s_setprio(0); } while (0)
#define PG8_WAIT_V(n) asm volatile("s_waitcnt vmcnt(" #n ")" ::: "memory")
#define PG8_WAIT_L(n) asm volatile("s_waitcnt lgkmcnt(" #n ")" ::: "memory")
#define PG8_BAR __builtin_amdgcn_s_barrier()
#define PG8_SCHED __builtin_amdgcn_sched_barrier(0)
    Unit cur, nxt; int ui = 0;
    if (!S.next(0, cur)) return;
    f32x4 acc[2][2][4][2];
#pragma unroll
    for (int a = 0; a < 2; ++a)
#pragma unroll
        for (int b = 0; b < 2; ++b)
#pragma unroll
            for (int m = 0; m < 4; ++m)
#pragma unroll
                for (int n = 0; n < 2; ++n) acc[a][b][m][n] = (f32x4){0.f, 0.f, 0.f, 0.f};
    bf16x8 At[4][2], B0[2][2], B1[2][2];
    const char* cA = (const char*)g.A + (size_t)cur.pm * tstep; const char* cB = (const char*)g.Bt + (size_t)cur.pn * tstep;
    S.a_ready(cur);
    if constexpr (SP2) {
        PG8_STAGE(PG8_SB(0, 0), cB, voffB); PG8_STAGE(PG8_SB(0, 1), cB + hstep, voffB); PG8_STAGE(PG8_SA(0, 0), cA, voffA); PG8_STAGE(PG8_SA(0, 1), cA + hstep, voffA);
        if (wr == 1) PG8_BAR;
        PG8_WAIT_V(2); PG8_BAR;
        PG8_STAGE(PG8_SB(1, 0), cB + kstep, voffB); PG8_STAGE(PG8_SA(1, 0), cA + kstep, voffA); PG8_STAGE(PG8_SB(1, 1), cB + hstep + kstep, voffB);
        PG8_WAIT_V(6); PG8_BAR;
    } else {
        PG8_STAGE(PG8_SB(0, 0), cB, voffB); PG8_STAGE(PG8_SA(0, 0), cA, voffA); PG8_STAGE(PG8_SB(0, 1), cB + hstep, voffB); PG8_STAGE(PG8_SA(0, 1), cA + hstep, voffA);
        if (wr == 1) PG8_BAR;
        PG8_WAIT_V(4); PG8_BAR;
        PG8_STAGE(PG8_SB(1, 0), cB + kstep, voffB); PG8_STAGE(PG8_SA(1, 0), cA + kstep, voffA); PG8_STAGE(PG8_SB(1, 1), cB + hstep + kstep, voffB);
        PG8_WAIT_V(6); PG8_BAR;
    }
    for (;;) {
        const bool has_next = S.next(ui + 1, nxt);
        const char* nA = has_next ? (const char*)g.A + (size_t)nxt.pm * tstep : cA; const char* nB = has_next ? (const char*)g.Bt + (size_t)nxt.pn * tstep : cB;
        for (int t = 0; t < nt; t += 2) {
            const bool last = (t == nt - 2);
            const char* a1 = cA + (size_t)(t + 1) * kstep;
            const char* a2 = last ? nA : cA + (size_t)(t + 2) * kstep; const char* b2 = last ? nB : cB + (size_t)(t + 2) * kstep;
            const char* a3 = a2 + kstep; const char* b3 = b2 + kstep;
            if (last && has_next) S.a_ready(nxt);
            if constexpr (SP2) {
            PG8_LDB(B0, 0, 0); PG8_LDB(B1, 0, 1); PG8_SCHED; PG8_LDA(At, 0, 0); PG8_STAGE(PG8_SA(1, 1), a1 + hstep, voffA);
            PG8_WAIT_V(8); PG8_WAIT_L(0); PG8_BAR; PG8_MMA(0, 0, At, B0); PG8_MMA(0, 1, At, B1); PG8_BAR; PG8_SCHED;
            PG8_LDA(At, 0, 1); PG8_STAGE(PG8_SB(0, 0), b2, voffB); PG8_STAGE(PG8_SB(0, 1), b2 + hstep, voffB); PG8_STAGE(PG8_SA(0, 0), a2, voffA);
            PG8_WAIT_V(8); PG8_WAIT_L(0); PG8_BAR; PG8_MMA(1, 0, At, B0); PG8_MMA(1, 1, At, B1); PG8_BAR; PG8_SCHED;
            PG8_LDB(B0, 1, 0); PG8_LDB(B1, 1, 1); PG8_SCHED; PG8_LDA(At, 1, 0); PG8_STAGE(PG8_SA(0, 1), a2 + hstep, voffA);
            PG8_WAIT_V(8); PG8_WAIT_L(0); PG8_BAR; PG8_MMA(0, 0, At, B0); PG8_MMA(0, 1, At, B1); PG8_BAR; PG8_SCHED;
            PG8_LDA(At, 1, 1); PG8_STAGE(PG8_SB(1, 0), b3, voffB); PG8_STAGE(PG8_SB(1, 1), b3 + hstep, voffB); PG8_STAGE(PG8_SA(1, 0), a3, voffA);
            PG8_WAIT_V(8); PG8_WAIT_L(0); PG8_BAR; PG8_MMA(1, 0, At, B0); PG8_MMA(1, 1, At, B1); PG8_BAR; PG8_SCHED;
            } else {
            PG8_LDB(B0, 0, 0); PG8_SCHED; PG8_LDA(At, 0, 0); PG8_STAGE(PG8_SA(1, 1), a1 + hstep, voffA);
            PG8_WAIT_L(8); PG8_BAR; PG8_WAIT_L(0); PG8_MMA(0, 0, At, B0); PG8_BAR; PG8_SCHED;
            PG8_LDB(B1, 0, 1); PG8_STAGE(PG8_SB(0, 0), b2, voffB);
            PG8_BAR; PG8_WAIT_L(0); PG8_MMA(0, 1, At, B1); PG8_BAR;
            PG8_LDA(At, 0, 1); PG8_STAGE(PG8_SA(0, 0), a2, voffA);
            PG8_BAR; PG8_WAIT_L(0); PG8_MMA(1, 0, At, B0); PG8_BAR; PG8_SCHED;
            PG8_STAGE(PG8_SB(0, 1), b2 + hstep, voffB);
            PG8_WAIT_V(6); PG8_BAR; PG8_MMA(1, 1, At, B1); PG8_BAR;
            PG8_LDB(B0, 1, 0); PG8_SCHED; PG8_LDA(At, 1, 0); PG8_STAGE(PG8_SA(0, 1), a2 + hstep, voffA);
            PG8_WAIT_L(8); PG8_BAR; PG8_WAIT_L(0); PG8_MMA(0, 0, At, B0); PG8_BAR; PG8_SCHED;
            PG8_LDB(B1, 1, 1); PG8_STAGE(PG8_SB(1, 0), b3, voffB);
            PG8_BAR; PG8_WAIT_L(0); PG8_MMA(0, 1, At, B1); PG8_BAR;
            PG8_LDA(At, 1, 1); PG8_STAGE(PG8_SA(1, 0), a3, voffA);
            PG8_BAR; PG8_WAIT_L(0); PG8_MMA(1, 0, At, B0); PG8_BAR; PG8_SCHED;
            PG8_STAGE(PG8_SB(1, 1), b3 + hstep, voffB);
            PG8_WAIT_V(6); PG8_BAR; PG8_MMA(1, 1, At, B1); PG8_BAR;
            }
        }
        if constexpr (ALIGN_EPI) { if (wr == 0) PG8_BAR; }
        if constexpr (!Epi::AFTER_DRAIN) { E(acc, cur, wr, wc, fr, fq); S.done(cur); }
        if (!has_next) break;
#pragma unroll
        for (int a = 0; a < 2; ++a)
#pragma unroll
            for (int b = 0; b < 2; ++b)
#pragma unroll
                for (int m = 0; m < 4; ++m)
#pragma unroll
                    for (int n = 0; n < 2; ++n) acc[a][b][m][n] = (f32x4){0.f, 0.f, 0.f, 0.f};
        cur = nxt; cA = nA; cB = nB; ++ui;
        if constexpr (ALIGN_EPI) { if (wr == 1) PG8_BAR; }
    }
    PG8_WAIT_V(0);
    if constexpr (!ALIGN_EPI) { if (wr == 0) PG8_BAR; }
    PG8_BAR;
    if constexpr (Epi::AFTER_DRAIN) { E.fused(acc, cur, wr, wc, fr, fq, lds, wid, lane); S.done(cur); }
#undef PG8_SA
#undef PG8_SB
#undef PG8_STAGE
#undef PG8_LDA
#undef PG8_LDB
#undef PG8_MMA
#undef PG8_WAIT_V
#undef PG8_WAIT_L
#undef PG8_BAR
#undef PG8_SCHED
}
}
namespace pg8 {
struct EpiF32 {
    static constexpr bool PERM = false, AFTER_DRAIN = false;
    float* C; int ldc; const float* bias;
    __device__ __forceinline__ void operator()(const f32x4 (&acc)[2][2][4][2], const Unit& u, int wr, int wc, int fr, int fq) const {
        const int row0 = u.pm * BM + wr * 64 + fr, col0 = u.pn * BM + wc * 32 + 4 * fq;
        f32x4 bv[2][2];
#pragma unroll
        for (int bj = 0; bj < 2; ++bj)
#pragma unroll
            for (int n = 0; n < 2; ++n) bv[bj][n] = bias ? *(const f32x4*)(bias + col0 + bj * HALF + n * 16) : (f32x4){0.f, 0.f, 0.f, 0.f};
#pragma unroll
        for (int ai = 0; ai < 2; ++ai)
#pragma unroll
            for (int m = 0; m < 4; ++m) { float* rowp = C + (size_t)(row0 + ai * HALF + m * 16) * ldc + col0;
#pragma unroll
                for (int bj = 0; bj < 2; ++bj)
#pragma unroll
                    for (int n = 0; n < 2; ++n) *(f32x4*)(rowp + bj * HALF + n * 16) = acc[ai][bj][m][n] + bv[bj][n]; }
    }
};
}

#define LAS __attribute__((address_space(3)))
typedef unsigned short bf16;
typedef unsigned v4u __attribute__((ext_vector_type(4)));
typedef unsigned v2u __attribute__((ext_vector_type(2)));
typedef int v4i __attribute__((ext_vector_type(4)));
typedef float f32x4 __attribute__((ext_vector_type(4)));
typedef float f32x16 __attribute__((ext_vector_type(16)));
typedef short bf16x8 __attribute__((ext_vector_type(8)));

constexpr int SEQ = 16384, DM = 2048, DEPTH = 4, NMEM = 256, DFF = 4096;
constexpr int D_IN = 4646, NP1 = 4864;
constexpr int C_QA = 0, C_KA = 512, C_VA = 1024, C_QB = 1536, C_KB = 2304, C_VB = 3072, C_CQ = 3840, C_CKV = 4352, C_KR = 4608, C_FB = 4640;
constexpr int NQC = 768, NKVC = 1280;
constexpr int NTAB = 611, RELC = 305;
constexpr float EPS = 1e-6f;
constexpr float LOG2E = 1.4426950408889634f;

constexpr size_t MiB = 1u << 20;
constexpr size_t WS_CTL = 0, WS_TAB = 1 * MiB, WS_COS = 2 * MiB, WS_SIN = 3 * MiB, WS_KRR = 4 * MiB, WS_LOGF = 5 * MiB, WS_CUMF = 6 * MiB,
                 WS_KVX = 7 * MiB, WS_MEMN = 8 * MiB, WS_VTX = 9 * MiB, WS_WT = 16 * MiB;
constexpr size_t WT_IN = 0, WT_UQ = 19 * MiB, WT_UKV = 20 * MiB, WT_OUT = 21 * MiB, WT_QX = 29 * MiB, WT_KVX = 31 * MiB, WT_OX = 35 * MiB, WT_UP = 37 * MiB, WT_DOWN = 69 * MiB;
constexpr size_t WS_H = 104 * MiB, WS_Y = 168 * MiB, WS_O = 296 * MiB, WS_QX = 360 * MiB, WS_OX = 376 * MiB, WS_CQN = 392 * MiB, WS_CKVN = 408 * MiB,
                 WS_A = 416 * MiB, WS_PROJ = 544 * MiB, WS_QC = 696 * MiB, WS_KVC = 720 * MiB, WS_VTA = 760 * MiB, WS_VTB = 776 * MiB, WS_VTC = 800 * MiB,
                 WS_U = 544 * MiB, WS_END = 824 * MiB;
constexpr int LDS_BYTES = 147456;

struct Params {
    const float* x; const float* mem; const int* pos; const float* rel_bias; const float* w_in; const float* b_forget; const float* lam; const float* q_norm;
    const float* kv_norm; const float* w_uq; const float* w_ukv; const float* head_norm; const float* w_out; const float* norm_gains; const float* mem_norm;
    const float* wq_x; const float* wkv_x; const float* wo_x; const float* w_up; const float* conv_w; const float* conv_b; const float* w_down;
    float* out; unsigned char* ws;
    float lam_init[4];
    int stop_phase; int pad;
};

#define LDS_WAIT() asm volatile("s_waitcnt lgkmcnt(0)" ::: "memory")
__device__ __forceinline__ unsigned f2bf(float f) { unsigned u = __builtin_bit_cast(unsigned, f); return (u + 0x7fffu + ((u >> 16) & 1u)) >> 16; }
__device__ __forceinline__ unsigned pk2(float lo, float hi) { return f2bf(lo) | (f2bf(hi) << 16); }
__device__ __forceinline__ float bflo(unsigned w) { return __builtin_bit_cast(float, w << 16); }
__device__ __forceinline__ float bfhi(unsigned w) { return __builtin_bit_cast(float, w & 0xffff0000u); }
__device__ __forceinline__ float wave_sum(float v) {
#pragma unroll
    for (int o = 1; o < 64; o <<= 1) v += __shfl_xor(v, o);
    return v;
}
__device__ __forceinline__ float swap32f(float v) { auto rr = __builtin_amdgcn_permlane32_swap(__builtin_bit_cast(unsigned, v), __builtin_bit_cast(unsigned, v), false, false);
    return __builtin_bit_cast(float, (__lane_id() & 32) ? rr[0] : rr[1]); }

struct MapIn  { static constexpr bool VEC = false; __device__ __forceinline__ int operator()(int d) const { return d < 3840 ? d : (d < 4640 ? d + 6 : (d < 4646 ? d - 800 : -1)); } };
struct MapPad { static constexpr bool VEC = true; int N; __device__ __forceinline__ int operator()(int d) const { return d < N ? d : -1; } };
template <class Map> __device__ __forceinline__ void wt_item(const float* __restrict__ W, int K, int N, bf16* __restrict__ WT, LAS float* scr, int kb, int db, int lane, Map cmap) {
    const int k0 = 64 * kb, d0 = 32 * db;
    if constexpr (Map::VEC) {
        const int krow = lane >> 3, c4 = (lane & 7) * 4; const bool valid = (d0 + c4) < N;
        const float* src = W + (size_t)(k0 + krow) * N + d0 + c4;
#pragma unroll
        for (int i = 0; i < 8; ++i) { f32x4 v = {0.f, 0.f, 0.f, 0.f}; if (valid) v = *(const f32x4*)(src + (size_t)(8 * i) * N);
            LAS float* d = scr + (8 * i + krow) * 33 + c4; d[0] = v.x; d[1] = v.y; d[2] = v.z; d[3] = v.w; }
    } else {
    const int c = cmap(d0 + (lane & 31));
    const float* src = W + (size_t)(k0 + (lane >> 5)) * N + (c >= 0 ? c : 0);
#pragma unroll 8
    for (int i = 0; i < 32; ++i) { const float v = src[(size_t)(2 * i) * N]; scr[(2 * i + (lane >> 5)) * 33 + (lane & 31)] = c >= 0 ? v : 0.f; }
    }
    LDS_WAIT();
    const int ch = lane & 7;
#pragma unroll
    for (int j = 0; j < 4; ++j) { const int n = (lane >> 3) + 8 * j; const LAS float* s = scr + (8 * ch) * 33 + n;
        v4u o; o.x = pk2(s[0 * 33], s[1 * 33]); o.y = pk2(s[2 * 33], s[3 * 33]); o.z = pk2(s[4 * 33], s[5 * 33]); o.w = pk2(s[6 * 33], s[7 * 33]);
        *(v4u*)(WT + (size_t)(d0 + n) * K + k0 + 8 * ch) = o; }
    LDS_WAIT();
}
template <class Map> __device__ __forceinline__ void wt_matrix(const float* W, int K, int N, int Npad, bf16* WT, LAS float* scr, int& base, int gw, int NGW, int lane, Map cmap) {
    const int nd = Npad / 32, items = (K / 64) * nd;
    int first = (gw - base % NGW + NGW) % NGW;
    for (int it = first; it < items; it += NGW) wt_item(W, K, N, WT, scr, it / nd, it % nd, lane, cmap);
    base += items;
}

__device__ __forceinline__ void norm_row(const float* xin, const bf16* y, const float* gpost, const float* gpre, float* xout, bf16* hout, int lane) {
    f32x4 v[8];
#pragma unroll
    for (int j = 0; j < 8; ++j) v[j] = ((const f32x4*)xin)[lane + 64 * j];
    if (y) {
        f32x4 yy[8]; float ss = 0.f;
#pragma unroll
        for (int j = 0; j < 8; ++j) { const v2u yw = ((const v2u*)y)[lane + 64 * j]; yy[j] = (f32x4){bflo(yw.x), bfhi(yw.x), bflo(yw.y), bfhi(yw.y)}; ss += (yy[j].x * yy[j].x + yy[j].y * yy[j].y) + (yy[j].z * yy[j].z + yy[j].w * yy[j].w); }
        const float r = 1.0f / sqrtf(wave_sum(ss) * (1.0f / DM) + EPS);
#pragma unroll
        for (int j = 0; j < 8; ++j) { const f32x4 g = ((const f32x4*)gpost)[lane + 64 * j]; v[j] = v[j] + yy[j] * r * g; }
    }
    if (xout) {
#pragma unroll
        for (int j = 0; j < 8; ++j) ((f32x4*)xout)[lane + 64 * j] = v[j];
    }
    if (hout) {
        float ss = 0.f;
#pragma unroll
        for (int j = 0; j < 8; ++j) ss += (v[j].x * v[j].x + v[j].y * v[j].y) + (v[j].z * v[j].z + v[j].w * v[j].w);
        const float r = 1.0f / sqrtf(wave_sum(ss) * (1.0f / DM) + EPS);
#pragma unroll
        for (int j = 0; j < 8; ++j) { const f32x4 g = ((const f32x4*)gpre)[lane + 64 * j]; const f32x4 h = v[j] * r * g;
            v2u o; o.x = pk2(h.x, h.y); o.y = pk2(h.z, h.w); ((v2u*)hout)[lane + 64 * j] = o; }
    }
}

__device__ __forceinline__ void prep1_row(const Params& p, int layer, int t, int lane) {
    const bf16* row = (const bf16*)(p.ws + WS_PROJ) + (size_t)t * NP1;
    { const v4u w = *(const v4u*)(row + C_CQ + lane * 8);
      float f[8] = {bflo(w.x), bfhi(w.x), bflo(w.y), bfhi(w.y), bflo(w.z), bfhi(w.z), bflo(w.w), bfhi(w.w)};
      float ss = 0.f;
#pragma unroll
      for (int j = 0; j < 8; ++j) ss += f[j] * f[j];
      const float r = 1.0f / sqrtf(wave_sum(ss) * (1.0f / 512) + EPS);
      const float* g = p.q_norm + layer * 512 + lane * 8;
      v4u o; o.x = pk2(f[0] * r * g[0], f[1] * r * g[1]); o.y = pk2(f[2] * r * g[2], f[3] * r * g[3]); o.z = pk2(f[4] * r * g[4], f[5] * r * g[5]); o.w = pk2(f[6] * r * g[6], f[7] * r * g[7]);
      *(v4u*)((bf16*)(p.ws + WS_CQN) + (size_t)t * 512 + lane * 8) = o; }
    { const v2u w = *(const v2u*)(row + C_CKV + lane * 4);
      float f[4] = {bflo(w.x), bfhi(w.x), bflo(w.y), bfhi(w.y)};
      float ss = (f[0] * f[0] + f[1] * f[1]) + (f[2] * f[2] + f[3] * f[3]);
      const float r = 1.0f / sqrtf(wave_sum(ss) * (1.0f / 256) + EPS);
      const float* g = p.kv_norm + layer * 256 + lane * 4;
      v2u o; o.x = pk2(f[0] * r * g[0], f[1] * r * g[1]); o.y = pk2(f[2] * r * g[2], f[3] * r * g[3]);
      *(v2u*)((bf16*)(p.ws + WS_CKVN) + (size_t)t * 256 + lane * 4) = o; }
    if (lane < 16) {
        const float t1 = __builtin_bit_cast(float, (unsigned)row[C_KR + lane] << 16), t2 = __builtin_bit_cast(float, (unsigned)row[C_KR + 16 + lane] << 16);
        const float cs = ((const float*)(p.ws + WS_COS))[t * 16 + lane], sn = ((const float*)(p.ws + WS_SIN))[t * 16 + lane];
        bf16* kr = (bf16*)(p.ws + WS_KRR) + (size_t)t * 32;
        kr[lane] = (bf16)f2bf(t1 * cs - t2 * sn); kr[16 + lane] = (bf16)f2bf(t2 * cs + t1 * sn);
    } else if (lane < 22) {
        const int h = lane - 16;
        const float xv = __builtin_bit_cast(float, (unsigned)row[C_FB + h] << 16) + p.b_forget[layer * 6 + h];
        const float ls = fminf(xv, 0.f) - log1pf(expf(-fabsf(xv)));
        ((float*)(p.ws + WS_LOGF))[h * SEQ + t] = ls;
    }
}
__device__ __forceinline__ void prep1_qknorm(const bf16* row, int lane, float (&mq)[2], float (&mk)[2]) {
#pragma unroll
    for (int j = 0; j < 2; ++j) {
        float sq = 0.f, sk = 0.f;
        if (j == 0 || lane < 32) {
            const v4u a = *(const v4u*)(row + C_QB + j * 512 + lane * 8), b = *(const v4u*)(row + C_KB + j * 512 + lane * 8);
            float f[8]; f[0] = bflo(a.x); f[1] = bfhi(a.x); f[2] = bflo(a.y); f[3] = bfhi(a.y); f[4] = bflo(a.z); f[5] = bfhi(a.z); f[6] = bflo(a.w); f[7] = bfhi(a.w);
#pragma unroll
            for (int e = 0; e < 8; ++e) sq += f[e] * f[e];
            f[0] = bflo(b.x); f[1] = bfhi(b.x); f[2] = bflo(b.y); f[3] = bfhi(b.y); f[4] = bflo(b.z); f[5] = bfhi(b.z); f[6] = bflo(b.w); f[7] = bfhi(b.w);
#pragma unroll
            for (int e = 0; e < 8; ++e) sk += f[e] * f[e];
        }
#pragma unroll
        for (int o = 1; o < 16; o <<= 1) { sq += __shfl_xor(sq, o); sk += __shfl_xor(sk, o); }
        mq[j] = fmaxf(mq[j], sq); mk[j] = fmaxf(mk[j], sk);
    }
}
__device__ __forceinline__ void vt_item(const bf16* src, int src_stride, bf16* dst, int dst_stride, LAS unsigned short* scr, int lane) {
#pragma unroll
    for (int i = 0; i < 8; ++i) { const int r = i * 8 + (lane >> 3), ch = lane & 7; const v4u w = *(const v4u*)(src + (size_t)r * src_stride + ch * 8);
        LAS unsigned* d = (LAS unsigned*)(scr + r * 66 + ch * 8); d[0] = w.x; d[1] = w.y; d[2] = w.z; d[3] = w.w; }
    LDS_WAIT();
#pragma unroll
    for (int i = 0; i < 8; ++i) { const int c = i * 8 + (lane >> 3), ch = lane & 7; const LAS unsigned short* s = scr + (ch * 8) * 66 + c;
        v4u o; o.x = (unsigned)s[0] | ((unsigned)s[66] << 16); o.y = (unsigned)s[2 * 66] | ((unsigned)s[3 * 66] << 16); o.z = (unsigned)s[4 * 66] | ((unsigned)s[5 * 66] << 16); o.w = (unsigned)s[6 * 66] | ((unsigned)s[7 * 66] << 16);
        *(v4u*)(dst + (size_t)c * dst_stride + ch * 8) = o; }
    LDS_WAIT();
}

typedef short s16x4 __attribute__((ext_vector_type(4)));
#define KSWZ(row, colB) ((row) * 256 + ((colB) ^ (((row) & 7) << 4)))
#define SBAR() __builtin_amdgcn_sched_barrier(0)
constexpr int AT_SHM_V = 16384, AT_SHM_K = 16384;
constexpr int AT_V = 0, AT_K = 49152, AT_WS = 98304, AT_TAB = 100352, AT_WORD = 102912;
__device__ __forceinline__ int crow(int r, int hi) { return (r & 3) + 8 * (r >> 2) + 4 * hi; }
__device__ __forceinline__ unsigned cvtpk(float lo, float hi) { unsigned r; asm volatile("v_cvt_pk_bf16_f32 %0, %1, %2" : "=v"(r) : "v"(lo), "v"(hi)); return r; }

__device__ __forceinline__ void partialSM(f32x16& p0, f32x16& p1, float& m_reg, float& alpha, float C, float thr_u) {
    float pmax = p0[0];
#pragma unroll
    for (int r = 1; r < 16; ++r) pmax = fmaxf(pmax, p0[r]);
#pragma unroll
    for (int r = 0; r < 16; ++r) pmax = fmaxf(pmax, p1[r]);
    pmax = fmaxf(pmax, __shfl_xor(pmax, 32));
    float mn;
    if (__builtin_expect(__all(pmax - m_reg <= thr_u), 1)) { mn = m_reg; alpha = 1.f; }
    else { mn = fmaxf(m_reg, pmax); alpha = __builtin_amdgcn_exp2f((m_reg - mn) * C); m_reg = mn; }
    const float mnC = -mn * C;
#pragma unroll
    for (int r = 0; r < 16; ++r) p0[r] = __builtin_fmaf(p0[r], C, mnC);
#pragma unroll
    for (int r = 0; r < 16; ++r) p1[r] = __builtin_fmaf(p1[r], C, mnC);
#pragma unroll
    for (int r = 0; r < 16; ++r) p0[r] = __builtin_amdgcn_exp2f(p0[r]);
}
__device__ __forceinline__ void finishSM(f32x16& p0, f32x16& p1, float alpha, float& l_reg, bf16x8& pa0, bf16x8& pa1, bf16x8& pa2, bf16x8& pa3) {
#pragma unroll
    for (int r = 0; r < 16; ++r) p1[r] = __builtin_amdgcn_exp2f(p1[r]);
    float ps = 0;
#pragma unroll
    for (int r = 0; r < 16; ++r) ps += p0[r];
#pragma unroll
    for (int r = 0; r < 16; ++r) ps += p1[r];
    ps += __shfl_xor(ps, 32);
    l_reg = l_reg * alpha + ps;
#define PK4(P, BASE, OUT) do { unsigned a0 = cvtpk(P[BASE + 0], P[BASE + 1]), a1 = cvtpk(P[BASE + 2], P[BASE + 3]);   \
    unsigned b0 = cvtpk(P[BASE + 4], P[BASE + 5]), b1 = cvtpk(P[BASE + 6], P[BASE + 7]);                              \
    auto r0 = __builtin_amdgcn_permlane32_swap(a0, b0, false, false); auto r1 = __builtin_amdgcn_permlane32_swap(a1, b1, false, false); \
    v4u w_ = {r0[0], r1[0], r0[1], r1[1]}; OUT = __builtin_bit_cast(bf16x8, w_); } while (0)
    PK4(p0, 0, pa0); PK4(p0, 8, pa1); PK4(p1, 0, pa2); PK4(p1, 8, pa3);
#undef PK4
}
__device__ __forceinline__ int v_st(int k, int c) { const int kk = (k & ~0xC) | ((k & 4) << 1) | ((k & 8) >> 1); return ((kk >> 3) * 4 + (c >> 5)) * 512 + ((kk & 7) * 32 + (c & 31)) * 2; }
__device__ __forceinline__ int v_rd_base(int lane) { return ((lane & 3) << 3) | (((lane >> 2) & 3) << 6) | (((lane >> 4) & 1) << 5) | (((lane >> 5) & 1) << 8); }
constexpr int v_rd_off(int d0, int ks, int half) { return d0 * 512 + ks * 4096 + half * 2048; }
template <int OFF> __device__ __forceinline__ s16x4 tr_read(int vb) { s16x4 r; asm volatile("ds_read_b64_tr_b16 %0, %1 offset:%2" : "=&v"(r) : "v"(vb), "i"(OFF) : "memory"); return r; }
template <int D0> __device__ __forceinline__ void pv_one(f32x16& od, int vb, bf16x8 pa0, bf16x8 pa1, bf16x8 pa2, bf16x8 pa3) {
    const s16x4 l0 = tr_read<v_rd_off(D0, 0, 0)>(vb), h0 = tr_read<v_rd_off(D0, 0, 1)>(vb), l1 = tr_read<v_rd_off(D0, 1, 0)>(vb), h1 = tr_read<v_rd_off(D0, 1, 1)>(vb);
    const s16x4 l2 = tr_read<v_rd_off(D0, 2, 0)>(vb), h2 = tr_read<v_rd_off(D0, 2, 1)>(vb), l3 = tr_read<v_rd_off(D0, 3, 0)>(vb), h3 = tr_read<v_rd_off(D0, 3, 1)>(vb);
    asm volatile("s_waitcnt lgkmcnt(0)" ::: "memory"); SBAR();
#define PKV(L, H) (bf16x8){L[0], L[1], L[2], L[3], H[0], H[1], H[2], H[3]}
    od = __builtin_amdgcn_mfma_f32_32x32x16_bf16(pa0, PKV(l0, h0), od, 0, 0, 0);
    od = __builtin_amdgcn_mfma_f32_32x32x16_bf16(pa1, PKV(l1, h1), od, 0, 0, 0);
    od = __builtin_amdgcn_mfma_f32_32x32x16_bf16(pa2, PKV(l2, h2), od, 0, 0, 0);
    od = __builtin_amdgcn_mfma_f32_32x32x16_bf16(pa3, PKV(l3, h3), od, 0, 0, 0);
#undef PKV
}
__device__ __forceinline__ void pv_d0(f32x16 (&o)[4], int vb, bf16x8 pa0, bf16x8 pa1, bf16x8 pa2, bf16x8 pa3) {
    pv_one<0>(o[0], vb, pa0, pa1, pa2, pa3); pv_one<1>(o[1], vb, pa0, pa1, pa2, pa3); pv_one<2>(o[2], vb, pa0, pa1, pa2, pa3); pv_one<3>(o[3], vb, pa0, pa1, pa2, pa3);
}

template <int DK, int MODE>
__device__ __forceinline__ void attn_pass(LAS unsigned char* lds, const bf16* __restrict__ Qp, int qs, const bf16* __restrict__ Kp, int ks, const bf16* __restrict__ K2p,
                                          const bf16* __restrict__ Vp, int vs, int q0, int t_begin, int NT, float C,
                                          const float* __restrict__ cumF, const int* __restrict__ pos, const float* __restrict__ cosT, const float* __restrict__ sinT,
                                          const int* __restrict__ pmax64, f32x16 (&o)[4]) {
    const int tid = tid_opaque(), wid = __builtin_amdgcn_readfirstlane(tid >> 6), lane = tid & 63, r32 = lane & 31, hi = lane >> 5;
    const int qrow = q0 + wid * 32 + r32;
#ifdef DBG_THR0
    const float thr_u = 0.0f;
#else
    const float thr_u = 8.0f * LOG2E / C;
#endif
    LAS const float* tab = (LAS const float*)(lds + AT_TAB);
    LAS float* wsl = (LAS float*)(lds + AT_WS) + wid * 64; LAS float* li_l = wsl; LAS float* al_l = wsl + 32;
    float m_reg = -1e30f, l_reg = 0.f;
#pragma unroll
    for (int d = 0; d < 4; ++d)
#pragma unroll
        for (int i = 0; i < 16; ++i) o[d][i] = 0.f;
    bf16x8 qr[DK / 16];
#pragma unroll
    for (int kk = 0; kk < DK / 16; ++kk) qr[kk] = *(const bf16x8*)(Qp + (size_t)qrow * qs + kk * 16 + hi * 8);
    if constexpr (MODE == 2) {
        const float* cp = cosT + (size_t)qrow * 16 + hi * 8; const float* sp = sinT + (size_t)qrow * 16 + hi * 8;
        bf16x8 a = qr[4], b = qr[5];
#pragma unroll
        for (int j = 0; j < 8; ++j) { const float t1 = __builtin_bit_cast(float, (unsigned)(unsigned short)a[j] << 16), t2 = __builtin_bit_cast(float, (unsigned)(unsigned short)b[j] << 16);
            const float cs = cp[j], sn = sp[j]; a[j] = (short)f2bf(t1 * cs - t2 * sn); b[j] = (short)f2bf(t2 * cs + t1 * sn); }
        qr[4] = a; qr[5] = b;
    }
    int posq = 0, qpmin = 0; float FrefS = 0.f;
    if constexpr (MODE == 0) { posq = pos[qrow]; int mn = posq;
#pragma unroll
        for (int s = 1; s < 64; s <<= 1) mn = min(mn, __shfl_xor(mn, s));
        qpmin = mn; }
    if constexpr (MODE == 1) FrefS = cumF[q0] * 11.313708498984761f;
    const int cq = (MODE == 3) ? NT : ((q0 + wid * 32) >> 6);
    const int sr = tid >> 4, cidx = tid & 15, sc = cidx * 8, vst0 = v_st(sr, sc), vst1 = v_st(32 + sr, sc);
    const bool kact = cidx < DK / 8;
    const int vb0 = (int)(unsigned)(uintptr_t)(lds + AT_V) + v_rd_base(lane);
    bf16x8 sv0[1], sv1[1], sk0[1], sk1[1];
#define KPTR(row) ((MODE == 2 && cidx >= 8) ? K2p + (size_t)(row) * 32 + (cidx - 8) * 8 : Kp + (size_t)(row) * ks + sc)
#define SLOAD(i, t) do { const int k0_ = (t) * 64; sv0[i] = *(const bf16x8*)(Vp + (size_t)(k0_ + sr) * vs + sc); sv1[i] = *(const bf16x8*)(Vp + (size_t)(k0_ + 32 + sr) * vs + sc); \
        if (kact) { sk0[i] = *(const bf16x8*)KPTR(k0_ + sr); sk1[i] = *(const bf16x8*)KPTR(k0_ + 32 + sr); } } while (0)
#define SWRITE(b, i) do { *(LAS bf16x8*)(lds + AT_V + (b) * AT_SHM_V + vst0) = sv0[i]; *(LAS bf16x8*)(lds + AT_V + (b) * AT_SHM_V + vst1) = sv1[i]; \
        if (kact) { *(LAS bf16x8*)(lds + AT_K + (b) * AT_SHM_K + KSWZ(sr, sc * 2)) = sk0[i]; *(LAS bf16x8*)(lds + AT_K + (b) * AT_SHM_K + KSWZ(32 + sr, sc * 2)) = sk1[i]; } } while (0)
#define SWAIT4() asm volatile("s_waitcnt vmcnt(4)" ::: "memory")
#define RESC(a) do { if (__any((a) < 1.f)) { if (hi == 0) al_l[r32] = (a); asm volatile("s_waitcnt lgkmcnt(0)" ::: "memory"); \
        _Pragma("unroll") for (int d = 0; d < 4; ++d) _Pragma("unroll") for (int r = 0; r < 16; ++r) o[d][r] *= al_l[crow(r, hi)]; } } while (0)
    auto qkt = [&](f32x16& p0, f32x16& p1, int kb, int t) {
        if constexpr (MODE == 0) { const float ci = (pmax64[t] - qpmin > -RELC) ? 0.f : tab[0];
#pragma unroll
            for (int i = 0; i < 16; ++i) { p0[i] = ci; p1[i] = ci; } }
        else if constexpr (MODE == 1) { const float* fp = cumF + t * 64 + 4 * hi;
#pragma unroll
            for (int g = 0; g < 4; ++g) { const f32x4 a = *(const f32x4*)(fp + 8 * g), b = *(const f32x4*)(fp + 32 + 8 * g);
#pragma unroll
                for (int e = 0; e < 4; ++e) { p0[4 * g + e] = __builtin_fmaf(a[e], -11.313708498984761f, FrefS); p1[4 * g + e] = __builtin_fmaf(b[e], -11.313708498984761f, FrefS); } } }
        else {
#pragma unroll
            for (int i = 0; i < 16; ++i) { p0[i] = 0.f; p1[i] = 0.f; } }
        LAS const unsigned char* Ks = lds + AT_K + kb * AT_SHM_K;
#pragma unroll
        for (int d0 = 0; d0 < DK / 16; ++d0) { const int cb = (d0 * 16 + hi * 8) * 2;
            const bf16x8 b0 = *(LAS const bf16x8*)(Ks + KSWZ(r32, cb));
            const bf16x8 b1 = *(LAS const bf16x8*)(Ks + KSWZ(32 + r32, cb));
            p0 = __builtin_amdgcn_mfma_f32_32x32x16_bf16(b0, qr[d0], p0, 0, 0, 0);
            p1 = __builtin_amdgcn_mfma_f32_32x32x16_bf16(b1, qr[d0], p1, 0, 0, 0); }
    };
    auto post = [&](f32x16& p0, f32x16& p1, int t) {
        if constexpr (MODE == 0) {
            if (pmax64[t] - qpmin > -RELC) {
                const int* pp = pos + t * 64 + 4 * hi;
#pragma unroll
                for (int g = 0; g < 4; ++g) { const v4i a = *(const v4i*)(pp + 8 * g), b = *(const v4i*)(pp + 32 + 8 * g);
#pragma unroll
                    for (int e = 0; e < 4; ++e) { const int ra = min(max(a[e] - posq, -RELC), RELC) + RELC, rb = min(max(b[e] - posq, -RELC), RELC) + RELC;
                        p0[4 * g + e] += tab[ra]; p1[4 * g + e] += tab[rb]; } }
            }
        }
        if constexpr (MODE == 1) {
            if (t == cq) { const int kb0 = t * 64 + 4 * hi;
#pragma unroll
                for (int i = 0; i < 16; ++i) { const int kv = kb0 + (i & 3) + 8 * (i >> 2); if (kv > qrow) p0[i] = -1e30f; if (kv + 32 > qrow) p1[i] = -1e30f; } }
        }
    };
    int tdense_end = (MODE == 3) ? NT : (q0 >> 6);
    int nd = tdense_end - t_begin; nd &= ~1; if (nd < 2) nd = 0;
#ifdef DBG_NODENSE
    nd = 0;
#endif
    const int tb = t_begin;
    if (nd) {
        f32x16 pA0, pA1, pB0, pB1; float alA, alB; bf16x8 pa0, pa1, pa2, pa3;
        SLOAD(0, tb); asm volatile("s_waitcnt vmcnt(0)" ::: "memory"); SWRITE(0, 0); __syncthreads();
        qkt(pA0, pA1, 0, tb); post(pA0, pA1, tb); partialSM(pA0, pA1, m_reg, alA, C, thr_u);
        SLOAD(0, tb + 1);
        SWRITE(1, 0); __syncthreads();
        int bp = 0, bc = 1, bn = 2;
        for (int j = 1; j + 1 < nd; j += 2) {
            SBAR(); qkt(pB0, pB1, bc, tb + j);
            finishSM(pA0, pA1, alA, l_reg, pa0, pa1, pa2, pa3); SBAR();
            SLOAD(0, tb + j + 1); SBAR();
            pv_d0(o, vb0 + bp * AT_SHM_V, pa0, pa1, pa2, pa3); post(pB0, pB1, tb + j); partialSM(pB0, pB1, m_reg, alB, C, thr_u);
            SWRITE(bn, 0);
            RESC(alB); __syncthreads();
            { const int t_ = bp; bp = bc; bc = bn; bn = t_; }
            SBAR(); qkt(pA0, pA1, bc, tb + j + 1);
            finishSM(pB0, pB1, alB, l_reg, pa0, pa1, pa2, pa3); SBAR();
            SLOAD(0, tb + j + 2); SBAR();
            pv_d0(o, vb0 + bp * AT_SHM_V, pa0, pa1, pa2, pa3); post(pA0, pA1, tb + j + 1); partialSM(pA0, pA1, m_reg, alA, C, thr_u);
            SWRITE(bn, 0);
            RESC(alA); __syncthreads();
            { const int t_ = bp; bp = bc; bc = bn; bn = t_; }
        }
        SBAR(); qkt(pB0, pB1, bc, tb + nd - 1);
        finishSM(pA0, pA1, alA, l_reg, pa0, pa1, pa2, pa3); SBAR();
        pv_d0(o, vb0 + bp * AT_SHM_V, pa0, pa1, pa2, pa3); post(pB0, pB1, tb + nd - 1); partialSM(pB0, pB1, m_reg, alB, C, thr_u);
        RESC(alB);
        finishSM(pB0, pB1, alB, l_reg, pa0, pa1, pa2, pa3); SBAR();
        pv_d0(o, vb0 + bc * AT_SHM_V, pa0, pa1, pa2, pa3);
        __syncthreads();
    }
    for (int t = tb + nd; t < NT; ++t) {
        SLOAD(0, t); asm volatile("s_waitcnt vmcnt(0)" ::: "memory"); SWRITE(0, 0); __syncthreads();
        if (t <= cq) {
            f32x16 p0, p1; float al; bf16x8 pa0, pa1, pa2, pa3;
            qkt(p0, p1, 0, t); post(p0, p1, t); partialSM(p0, p1, m_reg, al, C, thr_u);
            finishSM(p0, p1, al, l_reg, pa0, pa1, pa2, pa3);
            RESC(al);
            pv_d0(o, vb0, pa0, pa1, pa2, pa3);
        }
        __syncthreads();
    }
    if (hi == 0) li_l[r32] = l_reg;
    asm volatile("s_waitcnt lgkmcnt(0)" ::: "memory");
#pragma unroll
    for (int r = 0; r < 16; ++r) {
#ifdef DBG_DIRECT
        const float rl = 1.0f / __shfl(l_reg, crow(r, hi));
#else
        const float rl = __builtin_amdgcn_rcpf(li_l[crow(r, hi)]);
#endif
#pragma unroll
        for (int d = 0; d < 4; ++d) o[d][r] *= rl; }
#undef KPTR
#undef SLOAD
#undef SWRITE
#undef SWAIT4
#undef RESC
}

__device__ __forceinline__ void attn_finish(LAS unsigned char* lds, f32x16 (&o)[4], bool do_rms, float rr_scale, const float* gain, bf16* obuf, int ostride, int q0, int col0) {
    const int tid = tid_opaque(), wid = __builtin_amdgcn_readfirstlane(tid >> 6), lane = tid & 63, r32 = lane & 31, hi = lane >> 5;
    float g4[4] = {1.f, 1.f, 1.f, 1.f};
    if (gain) {
#pragma unroll
        for (int d = 0; d < 4; ++d) g4[d] = gain[col0 + d * 32 + r32];
    }
#ifdef DBG_DIRECT
#pragma unroll
    for (int r = 0; r < 16; ++r) {
        float rr = rr_scale;
        if (do_rms) {
            float ss = (o[0][r] * o[0][r] + o[1][r] * o[1][r]) + (o[2][r] * o[2][r] + o[3][r] * o[3][r]);
#pragma unroll
            for (int s = 1; s < 32; s <<= 1) ss += __shfl_xor(ss, s);
            rr = rr_scale / sqrtf(ss * (1.0f / 128) + EPS);
        }
        const int row = crow(r, hi);
#pragma unroll
        for (int d = 0; d < 4; ++d) obuf[(size_t)(q0 + wid * 32 + row) * ostride + col0 + d * 32 + r32] = (unsigned short)f2bf(o[d][r] * rr * g4[d]);
    }
}
#else
    LAS unsigned short* stg = (LAS unsigned short*)(lds + wid * 8192);
#pragma unroll
    for (int r = 0; r < 16; ++r) {
        float rr = rr_scale;
        if (do_rms) {
            float ss = (o[0][r] * o[0][r] + o[1][r] * o[1][r]) + (o[2][r] * o[2][r] + o[3][r] * o[3][r]);
#pragma unroll
            for (int s = 1; s < 32; s <<= 1) ss += __shfl_xor(ss, s);
            rr = rr_scale / sqrtf(ss * (1.0f / 128) + EPS);
        }
        const int row = crow(r, hi);
#pragma unroll
        for (int d = 0; d < 4; ++d) stg[row * 128 + d * 32 + r32] = (unsigned short)f2bf(o[d][r] * rr * g4[d]);
    }
    LDS_WAIT();
#pragma unroll
    for (int i = 0; i < 8; ++i) { const int c = i * 64 + lane, row = c >> 4, ch = c & 15;
        const v4u v = *(LAS const v4u*)(stg + row * 128 + ch * 8);
        *(v4u*)(obuf + (size_t)(q0 + wid * 32 + row) * ostride + col0 + ch * 8) = v; }
    LDS_WAIT();
}
#endif

__device__ __forceinline__ void self_attn_A(const Params& p, LAS unsigned char* lds, int layer, int h, int qb) {
    const int tid = tid_opaque(), lane = tid & 63, wid = __builtin_amdgcn_readfirstlane(tid >> 6);
    const int q0 = qb * 256, NT = q0 / 64 + 4;
    const bf16* proj = (const bf16*)(p.ws + WS_PROJ);
    { LAS float* tab = (LAS float*)(lds + AT_TAB); const float* tg = (const float*)(p.ws + WS_TAB) + h * NTAB; for (int i = tid; i < NTAB; i += 512) tab[i] = tg[i]; }
    __syncthreads();
    unsigned* park = (unsigned*)(p.ws + WS_VTA) + ((size_t)(blockIdx.x * 8 + wid) * 64 + lane) * 32;
    for (int mp = 0; mp < 2; ++mp) {
        f32x16 o[4];
        attn_pass<64, 0>(lds, proj + C_QA + h * 128 + mp * 64, NP1, proj + C_KA + h * 128 + mp * 64, NP1, nullptr, proj + C_VA + h * 128, NP1, q0, 0, NT, 0.125f * LOG2E,
                         nullptr, p.pos, nullptr, nullptr, (const int*)(p.ws + WS_TAB + 16384), o);
        if (mp == 0) {
#pragma unroll
            for (int d = 0; d < 4; ++d)
#pragma unroll
                for (int r = 0; r < 8; ++r) park[d * 8 + r] = pk2(o[d][2 * r], o[d][2 * r + 1]);
        } else {
            const float* lm = p.lam + layer * 256;
            const float d01 = wave_sum(lm[lane] * lm[64 + lane]), d23 = wave_sum(lm[128 + lane] * lm[192 + lane]);
            const float li = p.lam_init[layer], lamv = expf(d01) - expf(d23) + li;
            LDS_WAIT();
#pragma unroll
            for (int d = 0; d < 4; ++d)
#pragma unroll
                for (int r = 0; r < 8; ++r) { const unsigned w = __hip_atomic_load(park + d * 8 + r, __ATOMIC_RELAXED, __HIP_MEMORY_SCOPE_AGENT); o[d][2 * r] = bflo(w) - lamv * o[d][2 * r]; o[d][2 * r + 1] = bfhi(w) - lamv * o[d][2 * r + 1]; }
            attn_finish(lds, o, true, 1.0f - li, p.head_norm + layer * 2048, (bf16*)(p.ws + WS_O), DM, q0, h * 128);
        }
    }
}
__device__ __forceinline__ void self_attn_B(const Params& p, LAS unsigned char* lds, int layer, int h, int qb) {
    const int tid = tid_opaque();
    const int q0 = qb * 256, NT = q0 / 64 + 4;
    const bf16* proj = (const bf16*)(p.ws + WS_PROJ);
    const float* cumF = (const float*)(p.ws + WS_CUMF) + (size_t)h * SEQ;
    int t_begin = 0;
    {
        LAS int* tbp = (LAS int*)(lds + AT_WORD + 64);
        if (tid == 0) *tbp = q0 / 64;
        __syncthreads();
        const unsigned* nb = (const unsigned*)(p.ws + WS_CTL) + 64 + layer * 16 + h * 2;
        const float B = 0.08838834764831845f * sqrtf(__builtin_bit_cast(float, nb[0]) * __builtin_bit_cast(float, nb[1]));
        const float Fq = cumF[q0];
        if (tid < q0 / 64) { const float bound = 2.0f * B + (Fq - cumF[tid * 64 + 63]) + 9.0f; if (bound >= -105.0f) __hip_atomic_fetch_min(tbp, tid, __ATOMIC_RELAXED, __HIP_MEMORY_SCOPE_WORKGROUP); }
        __syncthreads();
        t_begin = __builtin_amdgcn_readfirstlane(*tbp);
    }
    f32x16 o[4];
    attn_pass<128, 1>(lds, proj + C_QB + h * 128, NP1, proj + C_KB + h * 128, NP1, nullptr, proj + C_VB + h * 128, NP1, q0, t_begin, NT, 0.08838834764831845f * LOG2E,
                      cumF, nullptr, nullptr, nullptr, nullptr, o);
    attn_finish(lds, o, true, 1.0f, p.head_norm + layer * 2048, (bf16*)(p.ws + WS_O), DM, q0, 512 + h * 128);
}
__device__ __forceinline__ void self_attn_C(const Params& p, LAS unsigned char* lds, int layer, int h, int qb) {
    const int q0 = qb * 256, NT = q0 / 64 + 4;
    f32x16 o[4];
    attn_pass<96, 2>(lds, (const bf16*)(p.ws + WS_QC) + h * 96, NQC, (const bf16*)(p.ws + WS_KVC) + h * 192, NKVC, (const bf16*)(p.ws + WS_KRR), (const bf16*)(p.ws + WS_KVC) + h * 192 + 64, NKVC,
                     q0, 0, NT, 0.10206207261596575f * LOG2E, nullptr, nullptr, (const float*)(p.ws + WS_COS), (const float*)(p.ws + WS_SIN), nullptr, o);
    attn_finish(lds, o, true, 1.0f, p.head_norm + layer * 2048, (bf16*)(p.ws + WS_O), DM, q0, 1280 + h * 128);
}

__device__ __forceinline__ float gelu_tanh(float x) {
    const float z = 0.7978845608028654f * (x + 0.044715f * x * x * x);
    const float e = __builtin_amdgcn_exp2f(z * (2.0f * LOG2E));
    const float th = 1.0f - 2.0f * __builtin_amdgcn_rcpf(e + 1.0f);
    return 0.5f * x * (1.0f + th);
}
__device__ __forceinline__ void unpack8(const v4u w, float (&f)[8]) { f[0] = bflo(w.x); f[1] = bfhi(w.x); f[2] = bflo(w.y); f[3] = bfhi(w.y); f[4] = bflo(w.z); f[5] = bfhi(w.z); f[6] = bflo(w.w); f[7] = bfhi(w.w); }
__device__ __forceinline__ void convgate_task(const Params& p, int layer, int rs, int cgp) {
    const bf16* U = (const bf16*)(p.ws + WS_U); bf16* A = (bf16*)(p.ws + WS_A);
    const int j0 = cgp * 8, t0 = rs * 32;
    const float* cw = p.conv_w + (size_t)layer * 3 * 8192; const float* cb = p.conv_b + (size_t)layer * 8192;
    float wg[3][8], wv[3][8], bg[8], bv[8];
#pragma unroll
    for (int tp = 0; tp < 3; ++tp)
#pragma unroll
        for (int j = 0; j < 8; ++j) { wg[tp][j] = cw[tp * 8192 + j0 + j]; wv[tp][j] = cw[tp * 8192 + 4096 + j0 + j]; }
#pragma unroll
    for (int j = 0; j < 8; ++j) { bg[j] = cb[j0 + j]; bv[j] = cb[4096 + j0 + j]; }
    float g2[8], g1[8], v2[8], v1[8];
#pragma unroll
    for (int j = 0; j < 8; ++j) { g2[j] = g1[j] = v2[j] = v1[j] = 0.f; }
    if (t0 >= 2) {
        unpack8(*(const v4u*)(U + (size_t)(t0 - 2) * 8192 + j0), g2); unpack8(*(const v4u*)(U + (size_t)(t0 - 2) * 8192 + 4096 + j0), v2);
        unpack8(*(const v4u*)(U + (size_t)(t0 - 1) * 8192 + j0), g1); unpack8(*(const v4u*)(U + (size_t)(t0 - 1) * 8192 + 4096 + j0), v1);
    }
#pragma unroll 4
    for (int t = t0; t < t0 + 32; ++t) {
        float g0[8], v0[8];
        unpack8(*(const v4u*)(U + (size_t)t * 8192 + j0), g0); unpack8(*(const v4u*)(U + (size_t)t * 8192 + 4096 + j0), v0);
        float r[8];
#pragma unroll
        for (int j = 0; j < 8; ++j) {
            const float cgv = bg[j] + g2[j] * wg[0][j] + g1[j] * wg[1][j] + g0[j] * wg[2][j];
            const float cvv = bv[j] + v2[j] * wv[0][j] + v1[j] * wv[1][j] + v0[j] * wv[2][j];
            r[j] = gelu_tanh(cgv) * cvv;
            g2[j] = g1[j]; g1[j] = g0[j]; v2[j] = v1[j]; v1[j] = v0[j];
        }
        v4u o; o.x = pk2(r[0], r[1]); o.y = pk2(r[2], r[3]); o.z = pk2(r[4], r[5]); o.w = pk2(r[6], r[7]);
        *(v4u*)(A + (size_t)t * 4096 + j0) = o;
    }
}

constexpr int CW_BAR = 4096, MISC_OFF = 139264;
#define XB_TMO      128
#define XB_XCNT(j)  (256  + 64 * (j))
#define XB_XSUB(j)  (1280 + 64 * (j))
#define XB_XGEN(j)  (2304 + 64 * (j))
#define XB_TOP      3328
#define XB_TOPGEN   3392
#define XCD_BAR_WORDS 3456
#define XB_SPIN_CAP (1u << 18)

__device__ __forceinline__ unsigned xb_ld(unsigned* p)              { return __hip_atomic_load(p, __ATOMIC_RELAXED, __HIP_MEMORY_SCOPE_AGENT); }
__device__ __forceinline__ unsigned xb_add(unsigned* p, unsigned v) { return __hip_atomic_fetch_add(p, v, __ATOMIC_RELAXED, __HIP_MEMORY_SCOPE_AGENT); }
__device__ __forceinline__ unsigned xb_xcc_id() { return (unsigned)__builtin_amdgcn_s_getreg((3 << 11) | 20) & 0xFu; }
#define XB_SPIN(cond, bar) do { unsigned _sp = 0; while (cond) { __builtin_amdgcn_s_sleep(1); \
    if ((++_sp & 255u) == 0u) { if (xb_ld(&(bar)[XB_TMO])) break; if (_sp > XB_SPIN_CAP) { atomicAdd(&(bar)[XB_TMO], 1u); break; } } } } while (0)

struct XcdBarrier {
    unsigned* bar; unsigned x;
    volatile LAS unsigned* st;
};

__device__ __forceinline__ XcdBarrier xcd_barrier_post(unsigned* bar, volatile LAS unsigned* st) {
    XcdBarrier b; b.bar = bar; b.x = xb_xcc_id(); b.st = st;
    if (threadIdx.x == 0) (void)xb_add(&bar[XB_XCNT(b.x)], 1u);
    return b;
}
__device__ __forceinline__ void xcd_barrier_complete(unsigned* bar, unsigned x, unsigned& nloc, unsigned& nx) {
    const unsigned G = gridDim.x * gridDim.y * gridDim.z;
    unsigned sum, cnt, mine, sp = 0u;
    for (;;) {
        sum = 0u; cnt = 0u; mine = 0u;
#pragma unroll
        for (unsigned j = 0; j < 16; ++j) { const unsigned c = xb_ld(&bar[XB_XCNT(j)]); sum += c; cnt += (c > 0u) ? 1u : 0u; mine = (j == x) ? c : mine; }
        if (sum == G) break;
        __builtin_amdgcn_s_sleep(1);
        if ((++sp & 255u) == 0u) { if (xb_ld(&bar[XB_TMO])) break; if (sp > XB_SPIN_CAP) { atomicAdd(&bar[XB_TMO], 1u); break; } }
    }
    nloc = mine > 0u ? mine : 1u; nx = cnt > 0u ? cnt : 1u;
}

__device__ __forceinline__ void xcd_barrier(const XcdBarrier& b) {
    asm volatile("s_waitcnt vmcnt(0)" ::: "memory");
    __syncthreads();
    if (threadIdx.x == 0) {
        unsigned* bar = b.bar;
        __builtin_amdgcn_s_waitcnt(0);
        unsigned nloc = b.st[0], nx = b.st[1];
        if (nloc == 0u) { xcd_barrier_complete(bar, b.x, nloc, nx); b.st[0] = nloc; b.st[1] = nx; }
        const unsigned old = xb_add(&bar[XB_XSUB(b.x)], 1u);
        const unsigned gen = old / nloc;
        if (old + 1u == (gen + 1u) * nloc) {
            __builtin_amdgcn_fence(__ATOMIC_RELEASE, "agent");
            asm volatile("s_waitcnt vmcnt(0)" ::: "memory");
            const unsigned og = xb_add(&bar[XB_TOP], 1u);
            const unsigned tg = og / nx;
            if (og + 1u == (tg + 1u) * nx) xb_add(&bar[XB_TOPGEN], 1u);
            else XB_SPIN(xb_ld(&bar[XB_TOPGEN]) == tg, bar);
            __builtin_amdgcn_fence(__ATOMIC_ACQUIRE, "agent");
            xb_add(&bar[XB_XGEN(b.x)], 1u);
            asm volatile("s_waitcnt vmcnt(0)" ::: "memory");
        } else {
            XB_SPIN(xb_ld(&bar[XB_XGEN(b.x)]) == gen, bar);
            __builtin_amdgcn_fence(__ATOMIC_ACQUIRE, "agent");
            asm volatile("s_waitcnt vmcnt(0)" ::: "memory");
        }
    }
    __syncthreads();
}

struct GemmJob { const bf16* A; const bf16* Bt; void* C; int M, N, K, ldc, f32, cshift; };
__device__ __forceinline__ GemmJob gemm_job(unsigned char* ws, int id) {
    GemmJob J;
    switch (id) {
    case 0:  J = GemmJob{(const bf16*)(ws + WS_H),    (const bf16*)(ws + WS_WT + WT_IN),   ws + WS_PROJ, SEQ,  NP1,  DM,  NP1,  0, 0};  break;
    case 1:  J = GemmJob{(const bf16*)(ws + WS_MEMN), (const bf16*)(ws + WS_WT + WT_KVX),  ws + WS_KVX,  NMEM, 1024, DM,  1024, 0, 64}; break;
    case 2:  J = GemmJob{(const bf16*)(ws + WS_CQN),  (const bf16*)(ws + WS_WT + WT_UQ),   ws + WS_QC,   SEQ,  NQC,  512, NQC,  0, 0};  break;
    case 3:  J = GemmJob{(const bf16*)(ws + WS_CKVN), (const bf16*)(ws + WS_WT + WT_UKV),  ws + WS_KVC,  SEQ,  NKVC, 256, NKVC, 0, 64}; break;
    case 4:  J = GemmJob{(const bf16*)(ws + WS_O),    (const bf16*)(ws + WS_WT + WT_OUT),  ws + WS_Y,    SEQ,  DM,   DM,  DM,   0, 0};  break;
    case 5:  J = GemmJob{(const bf16*)(ws + WS_H),    (const bf16*)(ws + WS_WT + WT_QX),   ws + WS_QX,   SEQ,  512,  DM,  512,  0, 0};  break;
    case 6:  J = GemmJob{(const bf16*)(ws + WS_OX),   (const bf16*)(ws + WS_WT + WT_OX),   ws + WS_Y,    SEQ,  DM,   512, DM,   0, 0};  break;
    case 7:  J = GemmJob{(const bf16*)(ws + WS_H),    (const bf16*)(ws + WS_WT + WT_UP),   ws + WS_U,    SEQ,  8192, DM,  8192, 0, 0};  break;
    default: J = GemmJob{(const bf16*)(ws + WS_A),    (const bf16*)(ws + WS_WT + WT_DOWN), ws + WS_Y,    SEQ,  DM,   DFF, DM,   0, 0};  break;
    }
    return J;
}

__global__ void __launch_bounds__(512, 2) mega_fwd(Params p_unused) {
    extern __shared__ __attribute__((aligned(16))) unsigned char lds_raw[];
    LAS unsigned char* lds = (LAS unsigned char*)lds_raw;
    cg::grid_group grid = cg::this_grid();
    const Params* pp0 = (const Params*)__builtin_amdgcn_kernarg_segment_ptr();
    const int G = gridDim.x, bx = blockIdx.x, NGW = G * 8;
    {
    const Params* pp = pp0; asm volatile("" : "+s"(pp));
    const Params& p = *pp;
    const int tid = tid_opaque();
    unsigned char* ws = p.ws;
    unsigned* ctl = (unsigned*)(ws + WS_CTL);
    {
        if (bx == 0) for (int i = tid; i < CW_BAR + XCD_BAR_WORDS; i += 512) ctl[i] = 0u;
        if (tid < 2) ((LAS unsigned*)(lds + MISC_OFF))[tid] = 0u;
        const int gt = bx * 512 + tid, NT_ = G * 512;
        for (int i = gt; i < SEQ * 16; i += NT_) {
            const int t = i >> 4, k = i & 15;
            const float inv = (float)exp(-(double)(2 * k) / 32.0 * 9.210340371976184);
            const float ang = (float)p.pos[t] * inv;
            const double xd = (double)ang, kq = rint(xd * 0.6366197723675814), r = (xd - kq * 1.5707963267948966) - kq * 6.123233995736766e-17, r2 = r * r;
            const double sn = r * (1.0 + r2 * (-1.0 / 6 + r2 * (1.0 / 120 + r2 * (-1.0 / 5040 + r2 * (1.0 / 362880 - r2 / 39916800)))));
            const double cs = 1.0 + r2 * (-0.5 + r2 * (1.0 / 24 + r2 * (-1.0 / 720 + r2 * (1.0 / 40320 + r2 * (-1.0 / 3628800 + r2 / 479001600)))));
            const int q = (int)((long long)kq & 3);
            const double s_ = (q == 0) ? sn : (q == 1) ? cs : (q == 2) ? -sn : -cs, c_ = (q == 0) ? cs : (q == 1) ? -sn : (q == 2) ? -cs : sn;
            ((float*)(ws + WS_COS))[i] = (float)c_; ((float*)(ws + WS_SIN))[i] = (float)s_;
        }
        for (int i = gt; i < 4 * NTAB; i += NT_) {
            const int h = i / NTAB, rel = i % NTAB - RELC, n = rel < 0 ? -rel : rel;
            const float nf = (float)(n > 1 ? n : 1);
            int large = 8 + (int)(logf(nf / 8.0f) / 4.1588830833596715f * 8.0f); large = large < 15 ? large : 15;
            const int bucket = (rel > 0 ? 16 : 0) + (n < 8 ? n : large);
            ((float*)(ws + WS_TAB))[i] = p.rel_bias[bucket * 4 + h] * 8.0f;
        }
        for (int i = gt; i < SEQ / 64; i += NT_) { int mx = p.pos[i * 64]; for (int j = 1; j < 64; ++j) mx = max(mx, p.pos[i * 64 + j]); ((int*)(ws + WS_TAB + 16384))[i] = mx; }
    }
    }

    constexpr int NSTEP = 14;
    for (int step = 0; step <= DEPTH * NSTEP; ++step) {
        const Params* pp = pp0; asm volatile("" : "+s"(pp));
        const Params& p = *pp;
        const int tid = tid_opaque();
        const int lane = tid & 63, wave = __builtin_amdgcn_readfirstlane(tid >> 6), gw = bx * 8 + wave;
        unsigned char* ws = p.ws;
        unsigned* ctl = (unsigned*)(ws + WS_CTL);
        const int layer = step / NSTEP, k = step - layer * NSTEP;
        int job0 = 0, njob = 0;
        switch (k) {
        case 0: {
#ifndef NO_WN
            if (layer < DEPTH) {
                LAS float* scr = (LAS float*)(lds + wave * 16384);
                int base = 0;
                wt_matrix(p.w_in + (size_t)layer * DM * D_IN, DM, D_IN, NP1, (bf16*)(ws + WS_WT + WT_IN), scr, base, gw, NGW, lane, MapIn{});
                wt_matrix(p.w_uq + (size_t)layer * 512 * 576, 512, 576, NQC, (bf16*)(ws + WS_WT + WT_UQ), scr, base, gw, NGW, lane, MapPad{576});
                wt_matrix(p.w_ukv + (size_t)layer * 256 * 1152, 256, 1152, NKVC, (bf16*)(ws + WS_WT + WT_UKV), scr, base, gw, NGW, lane, MapPad{1152});
                wt_matrix(p.w_out + (size_t)layer * DM * DM, DM, DM, DM, (bf16*)(ws + WS_WT + WT_OUT), scr, base, gw, NGW, lane, MapPad{DM});
                wt_matrix(p.wq_x + (size_t)layer * DM * 512, DM, 512, 512, (bf16*)(ws + WS_WT + WT_QX), scr, base, gw, NGW, lane, MapPad{512});
                wt_matrix(p.wkv_x + (size_t)layer * DM * 1024, DM, 1024, 1024, (bf16*)(ws + WS_WT + WT_KVX), scr, base, gw, NGW, lane, MapPad{1024});
                wt_matrix(p.wo_x + (size_t)layer * 512 * DM, 512, DM, DM, (bf16*)(ws + WS_WT + WT_OX), scr, base, gw, NGW, lane, MapPad{DM});
                wt_matrix(p.w_up + (size_t)layer * DM * 8192, DM, 8192, 8192, (bf16*)(ws + WS_WT + WT_UP), scr, base, gw, NGW, lane, MapPad{8192});
                wt_matrix(p.w_down + (size_t)layer * DFF * DM, DFF, DM, DM, (bf16*)(ws + WS_WT + WT_DOWN), scr, base, gw, NGW, lane, MapPad{DM});
                for (int r = gw; r < NMEM; r += NGW) norm_row(p.mem + (size_t)r * DM, nullptr, nullptr, p.mem_norm + (size_t)layer * DM, nullptr, (bf16*)(ws + WS_MEMN) + (size_t)r * DM, lane);
            }
#endif
        }
        case 6: case 10: {
            const float* xin = (step == 0) ? p.x : p.out;
            const bf16* y = (step == 0) ? nullptr : (const bf16*)(ws + WS_Y);
            const float* gpost = (k == 0) ? p.norm_gains + (size_t)((layer > 0 ? layer - 1 : 0) * 6 + 5) * DM : p.norm_gains + (size_t)(layer * 6 + (k == 6 ? 1 : 3)) * DM;
            const float* gpre = (layer < DEPTH) ? p.norm_gains + (size_t)(layer * 6 + (k == 0 ? 0 : (k == 6 ? 2 : 4))) * DM : nullptr;
            for (int r = gw; r < SEQ; r += NGW)
                norm_row(xin + (size_t)r * DM, y ? y + (size_t)r * DM : nullptr, gpost, gpre, p.out + (size_t)r * DM, gpre ? (bf16*)(ws + WS_H) + (size_t)r * DM : nullptr, lane);
        } break;
        case 1: job0 = 0; njob = 2; break;
        case 2: {
#ifndef NO_PREP1
            { float mq[2] = {0.f, 0.f}, mk[2] = {0.f, 0.f};
              for (int t = gw; t < SEQ; t += NGW) { prep1_row(p, layer, t, lane); prep1_qknorm((const bf16*)(ws + WS_PROJ) + (size_t)t * NP1, lane, mq, mk); }
              if ((lane & 15) == 0) { const int g = lane >> 4;
                  atomicMax(&ctl[64 + layer * 16 + g * 2], __builtin_bit_cast(unsigned, mq[0])); atomicMax(&ctl[64 + layer * 16 + g * 2 + 1], __builtin_bit_cast(unsigned, mk[0]));
                  if (g < 2) { atomicMax(&ctl[64 + layer * 16 + (4 + g) * 2], __builtin_bit_cast(unsigned, mq[1])); atomicMax(&ctl[64 + layer * 16 + (4 + g) * 2 + 1], __builtin_bit_cast(unsigned, mk[1])); } } }
#endif
        } break;
        case 3: {
#ifndef NO_PREP1
            if (bx < 6) {
                const float* lf = (const float*)(ws + WS_LOGF) + (size_t)bx * SEQ + tid * 32; float* cf = (float*)(ws + WS_CUMF) + (size_t)bx * SEQ + tid * 32;
                f32x4 v[8]; double loc = 0.0;
#pragma unroll
                for (int j = 0; j < 8; ++j) { v[j] = ((const f32x4*)lf)[j]; loc += ((double)v[j].x + (double)v[j].y) + ((double)v[j].z + (double)v[j].w); }
                double inc = loc;
#pragma unroll
                for (int o = 1; o < 64; o <<= 1) { const double n = __shfl_up(inc, o); if (lane >= o) inc += n; }
                LAS double* wt = (LAS double*)(lds + 131072);
                if (lane == 63) wt[wave] = inc;
                __syncthreads();
                double off = inc - loc;
                for (int kk = 0; kk < wave; ++kk) off += wt[kk];
                __syncthreads();
#pragma unroll
                for (int j = 0; j < 8; ++j) { f32x4 o; off += (double)v[j].x; o.x = (float)off; off += (double)v[j].y; o.y = (float)off; off += (double)v[j].z; o.z = (float)off; off += (double)v[j].w; o.w = (float)off; ((f32x4*)cf)[j] = o; }
            }
#endif
            job0 = 2; njob = 2;
        } break;
        case 4: {
#ifndef NO_ATTN
            LAS volatile unsigned* word = (LAS volatile unsigned*)(lds + AT_WORD);
#ifdef PROBE_ATTN2
            for (int rep = 0; rep < 2; ++rep) { if (rep) grid.sync();
#else
            { const int rep = 0;
#endif
            for (;;) {
                if (tid == 0) *word = atomicAdd(&ctl[layer + 8 * rep], 1u);
                __syncthreads();
                const int idx = __builtin_amdgcn_readfirstlane((int)*word);
                __syncthreads();
                if (idx >= 1024) break;
                if (idx < 128) self_attn_A(p, lds, layer, idx & 3, 63 - (idx >> 2));
                else if (idx < 640) { const int i2 = idx - 128, m = 32 - (i2 >> 4), r = i2 & 15;
                    if (r < 4) self_attn_A(p, lds, layer, r, m - 1);
                    else if (r < 10) self_attn_C(p, lds, layer, r - 4, 2 * m - 1);
                    else self_attn_C(p, lds, layer, r - 10, 2 * m - 2); }
                else { const int r = idx - 640; self_attn_B(p, lds, layer, r % 6, 63 - r / 6); }
            }
            }
#endif
        } break;
        case 5: job0 = 4; njob = 1; break;
        case 7: job0 = 5; njob = 1; break;
        case 8: {
#ifndef NO_XATTN
            for (int u = bx; u < 256; u += G) {
                const int h = u & 3, qb = u >> 2, q0 = qb * 256;
                f32x16 o[4];
                attn_pass<128, 3>(lds, (const bf16*)(ws + WS_QX) + h * 128, 512, (const bf16*)(ws + WS_KVX) + h * 128, 1024, nullptr, (const bf16*)(ws + WS_KVX) + 512 + h * 128, 1024, q0, 0, 4,
                                  0.08838834764831845f * LOG2E, nullptr, nullptr, nullptr, nullptr, nullptr, o);
                attn_finish(lds, o, false, 1.0f, nullptr, (bf16*)(ws + WS_OX), 512, q0, h * 128);
                __syncthreads();
            }
#endif
        } break;
        case 9: job0 = 6; njob = 1; break;
        case 11: job0 = 7; njob = 1; break;
        case 12: {
#ifndef NO_CONV
            for (int task = bx * 512 + tid; task < 512 * 512; task += G * 512) convgate_task(p, layer, task >> 9, task & 511);
#endif
        } break;
        default: job0 = 8; njob = 1; break;
        }
#ifndef NO_GEMM
#ifdef PROBE_GEMM2
        for (int jj2 = 0; jj2 < 2 * njob; ++jj2) { const int jj = jj2 % njob;
#else
        for (int jj = 0; jj < njob; ++jj) {
#endif
            const GemmJob J = gemm_job(ws, job0 + jj);
            pg8::Gemm g{J.A, J.Bt, J.M, J.N, J.K}; pg8::StaticOrder S; S.init(J.M, J.N, G, (bx + J.cshift) % G);
            if (J.f32) { pg8::EpiF32 E{(float*)J.C, J.ldc, nullptr}; pg8::gemm_phase<pg8::EpiF32, pg8::StaticOrder, true, true>(lds, g, S, E); }
            else { pg8::EpiBf16<0> E{(bf16*)J.C, J.ldc, nullptr, 0, 0, 1.f}; pg8::gemm_phase<pg8::EpiBf16<0>, pg8::StaticOrder, true, true>(lds, g, S, E); }
        }
#endif
        if (step == DEPTH * NSTEP) break;
        if (step == 0) { grid.sync(); (void)xcd_barrier_post(ctl + CW_BAR, (volatile LAS unsigned*)(lds + MISC_OFF)); }
        else { XcdBarrier b; b.bar = ctl + CW_BAR; b.x = xb_xcc_id(); b.st = (volatile LAS unsigned*)(lds + MISC_OFF); xcd_barrier(b); }
        { const Params* pq = pp0; asm volatile("" : "+s"(pq)); if (pq->stop_phase && step + 1 >= pq->stop_phase) return; }
    }
}

extern "C" void kernel_launch(void* const* d_in, const int* in_sizes, int n_in, void* d_out, int out_size, void* d_ws, size_t ws_size, hipStream_t stream) {
    static int grid = 0;
    if (grid == 0) {
        if (n_in != 22 || out_size != SEQ * DM || ws_size < WS_END) { fprintf(stderr, "kernel_launch: unexpected shapes (n_in %d, out %d, ws %zu < %zu)\n", n_in, out_size, ws_size, (size_t)WS_END); grid = -1; return; }
        int dev = 0, cus = 0, per_cu = 0;
        if (hipGetDevice(&dev) != hipSuccess || hipDeviceGetAttribute(&cus, hipDeviceAttributeMultiprocessorCount, dev) != hipSuccess) { fprintf(stderr, "kernel_launch: device query failed\n"); grid = -1; return; }
        if (hipFuncSetAttribute((const void*)mega_fwd, hipFuncAttributeMaxDynamicSharedMemorySize, LDS_BYTES) != hipSuccess) { fprintf(stderr, "kernel_launch: hipFuncSetAttribute failed\n"); grid = -1; return; }
        if (hipOccupancyMaxActiveBlocksPerMultiprocessor(&per_cu, (const void*)mega_fwd, 512, LDS_BYTES) != hipSuccess || per_cu < 1) { fprintf(stderr, "kernel_launch: occupancy query says %d blocks per CU\n", per_cu); (void)hipGetLastError(); per_cu = 1; }
        grid = cus * (per_cu > 1 ? 1 : per_cu);
        fprintf(stderr, "kernel_launch: grid %d (cus %d, per_cu %d)\n", grid, cus, per_cu);
    }
    if (grid < 0) return;
    Params p{};
    p.x = (const float*)d_in[0]; p.mem = (const float*)d_in[1]; p.pos = (const int*)d_in[2]; p.rel_bias = (const float*)d_in[3]; p.w_in = (const float*)d_in[4];
    p.b_forget = (const float*)d_in[5]; p.lam = (const float*)d_in[6]; p.q_norm = (const float*)d_in[7]; p.kv_norm = (const float*)d_in[8]; p.w_uq = (const float*)d_in[9];
    p.w_ukv = (const float*)d_in[10]; p.head_norm = (const float*)d_in[11]; p.w_out = (const float*)d_in[12]; p.norm_gains = (const float*)d_in[13]; p.mem_norm = (const float*)d_in[14];
    p.wq_x = (const float*)d_in[15]; p.wkv_x = (const float*)d_in[16]; p.wo_x = (const float*)d_in[17]; p.w_up = (const float*)d_in[18]; p.conv_w = (const float*)d_in[19];
    p.conv_b = (const float*)d_in[20]; p.w_down = (const float*)d_in[21];
    p.out = (float*)d_out; p.ws = (unsigned char*)d_ws;
    for (int i = 0; i < 4; ++i) p.lam_init[i] = (float)(0.8 - 0.6 * exp(-0.3 * i));
    p.stop_phase = 0; p.pad = 0;
    void* args[] = {&p};
    hipError_t e = hipLaunchCooperativeKernel((const void*)mega_fwd, dim3(grid), dim3(512), args, LDS_BYTES, stream);
    if (e != hipSuccess) fprintf(stderr, "kernel_launch: cooperative launch failed: %s (grid %d)\n", hipGetErrorString(e), grid);
}
```

```cpp
#include <hip/hip_runtime.h>
#include <hip/hip_cooperative_groups.h>
#include <cstdio>
#include <cstdint>
namespace cg = cooperative_groups;
__device__ __forceinline__ int tid_opaque() { int t = threadIdx.x; asm volatile("" : "+v"(t)); return t; }
namespace pg8 {
#define PG8_LAS __attribute__((address_space(3)))
typedef unsigned short bf16_t;
typedef short bf16x8 __attribute__((ext_vector_type(8)));
typedef float f32x4 __attribute__((ext_vector_type(4)));
typedef unsigned u32x4 __attribute__((ext_vector_type(4)));
constexpr int BM = 256, BK = 64, HALF = 128, HTB = HALF * BK * 2  , STAGE_BYTES = 8 * HTB, NXCD = 8, WGM = 8;

__host__ __device__ __forceinline__ int lds_byte(int r, int c) { const int st = (r >> 4) * 2 + (c >> 5), rr = r & 15, cc = c & 31, ob = rr * 64 + cc * 2; return st * 1024 + (ob ^ (((ob >> 9) & 1) << 5)); }
__host__ __device__ __forceinline__ void stage_rc(int b, int& R, int& C) { const int st = b / 1024, sb = b % 1024, swz = sb ^ (((sb >> 9) & 1) << 5); R = (st >> 1) * 16 + swz / 64; C = (st & 1) * 32 + (swz % 64) / 2; }
__host__ __device__ __forceinline__ int perm32(int rho) { const int n = rho >> 4, i = rho & 15; return 8 * (i >> 2) + 4 * n + (i & 3); }

struct Unit { int pm, pn; };
struct Gemm { const bf16_t* A; const bf16_t* Bt; int M, N, K; };

struct StaticOrder {
    int nM, nN, nwg, G, c;
    __host__ __device__ void init(int M, int N, int G_, int c_) { nM = M / BM; nN = N / BM; nwg = nM * nN; G = G_; c = c_; }
    __host__ __device__ bool next(int i, Unit& u) const {
        const long L = (long)i * G + c; if (L >= nwg) return false;
        int wgid = (int)L; { const int q = nwg / NXCD, r = nwg % NXCD, xcd = wgid % NXCD, off = wgid / NXCD; wgid = (xcd < r ? xcd * (q + 1) : r * (q + 1) + (xcd - r) * q) + off; }
        const int nig = WGM * nN, gid = wgid / nig, fm = gid * WGM, gsz = (nM - fm) < WGM ? (nM - fm) : WGM;
        u.pm = fm + ((wgid % nig) % gsz); u.pn = (wgid % nig) / gsz; return true;
    }
    __device__ __forceinline__ void a_ready(const Unit&) const {}
    __device__ __forceinline__ void done(const Unit&) const {}
};

__device__ __forceinline__ unsigned cvt_pk_bf16(float lo, float hi) { unsigned r; asm volatile("v_cvt_pk_bf16_f32 %0, %1, %2" : "=v"(r) : "v"(lo), "v"(hi)); return r; }
typedef float f32x2 __attribute__((ext_vector_type(2)));
__device__ __forceinline__ f32x2 gelu_pk(f32x2 v) {
    const f32x2 av = __builtin_elementwise_abs(v), d = av * 0.2316418882f + 1.0f;
    f32x2 t; t.x = __builtin_amdgcn_rcpf(d.x); t.y = __builtin_amdgcn_rcpf(d.y);
    f32x2 q = t * 0.5307027145f + (-0.7265760135f); q = q * t + 0.7107068705f; q = q * t + (-0.142248368f); q = q * t + 0.127414796f; q = q * t;
    const f32x2 s = (v * v) * (-0.72134752044f);
    f32x2 e; e.x = __builtin_amdgcn_exp2f(s.x); e.y = __builtin_amdgcn_exp2f(s.y);
    const f32x2 m = v * (q * e), r = v - m;
    f32x2 o; o.x = v.x < 0.f ? m.x : r.x; o.y = v.y < 0.f ? m.y : r.y; return o;
}

template <int ACT  > struct EpiBf16 {
    static constexpr bool PERM = true, AFTER_DRAIN = false; static_assert(ACT == 0 || ACT == 1, "EpiBf16: ACT is 0 (none) or 1 (gelu_pk)");
    bf16_t* O; int ldc; const float* bias; int split_cols; size_t split_stride; float scale0;
    __device__ __forceinline__ void operator()(const f32x4 (&acc)[2][2][4][2], const Unit& u, int wr, int wc, int fr, int fq) const {
        const int row0 = u.pm * BM + wr * 64 + fr; int colt = u.pn * BM; bf16_t* base = O;
        float sc = 1.f; if (split_cols) { const int t = colt / split_cols; base += (size_t)t * split_stride; colt -= t * split_cols; if (t == 0) sc = scale0; }
        const int col0 = colt + wc * 32 + 8 * fq, bcol0 = u.pn * BM + wc * 32 + 8 * fq;
        f32x4 bv[2][2];
#pragma unroll
        for (int bj = 0; bj < 2; ++bj)
#pragma unroll
            for (int n = 0; n < 2; ++n) bv[bj][n] = bias ? *(const f32x4*)(bias + bcol0 + bj * HALF + 4 * n) : (f32x4){0.f, 0.f, 0.f, 0.f};
#pragma unroll
        for (int ai = 0; ai < 2; ++ai)
#pragma unroll
            for (int m = 0; m < 4; ++m) { bf16_t* rowp = base + (size_t)(row0 + ai * HALF + m * 16) * ldc + col0;
#pragma unroll
                for (int bj = 0; bj < 2; ++bj) { f32x4 v0 = acc[ai][bj][m][0] + bv[bj][0], v1 = acc[ai][bj][m][1] + bv[bj][1];
                    if (ACT == 1) { f32x2 a = gelu_pk((f32x2){v0[0], v0[1]}), b = gelu_pk((f32x2){v0[2], v0[3]}), c = gelu_pk((f32x2){v1[0], v1[1]}), d = gelu_pk((f32x2){v1[2], v1[3]});
                        v0 = (f32x4){a.x, a.y, b.x, b.y}; v1 = (f32x4){c.x, c.y, d.x, d.y}; }
                    v0 = v0 * sc; v1 = v1 * sc; u32x4 w; w.x = cvt_pk_bf16(v0[0], v0[1]); w.y = cvt_pk_bf16(v0[2], v0[3]); w.z = cvt_pk_bf16(v1[0], v1[1]); w.w = cvt_pk_bf16(v1[2], v1[3]);
                    *(u32x4*)(rowp + bj * HALF) = w; } }
    }
};


template <class Epi, class Sched, bool ALIGN_EPI = false, bool SP2 = false>
__device__ __forceinline__ void gemm_phase(PG8_LAS unsigned char* lds, const Gemm g, const Sched& S, const Epi& E) {
    const int tid = tid_opaque(), wid = __builtin_amdgcn_readfirstlane(tid >> 6), lane = tid & 63, wr = wid >> 2, wc = wid & 3, fr = lane & 15, fq = lane >> 4;
    const int K = g.K, nt = K / BK;
    unsigned voffA[2], voffB[2];
#pragma unroll
    for (int i = 0; i < 2; ++i) { int R, C; stage_rc(tid * 16 + i * 8192, R, C); const int Rb = Epi::PERM ? ((R & ~31) + perm32(R & 31)) : R;
        voffA[i] = (unsigned)(R * K + C) * 2u; voffB[i] = (unsigned)(Rb * K + C) * 2u; }
    const size_t kstep = (size_t)(BK * 2);
    const size_t hstep = (size_t)HALF * K * 2;
    const size_t tstep = 2 * hstep;
    const unsigned ldsw = (unsigned)wid * 1024u;
    const int aoff = lds_byte(wr * 64 + fr, fq * 8), boff = lds_byte(wc * 32 + fr, fq * 8);
#define PG8_SA(b, h) (((b) * 2 + (h)) * HTB)
#define PG8_SB(b, h) ((4 + (b) * 2 + (h)) * HTB)
#define PG8_STAGE(bufoff, gbase, voff) do { _Pragma("unroll") for (int _i = 0; _i < 2; ++_i) \
        __builtin_amdgcn_global_load_lds((const unsigned*)((const char*)(gbase) + (voff)[_i]), (PG8_LAS unsigned*)(lds + (bufoff) + ldsw + _i * 8192), 16, 0, 0); } while (0)
#define PG8_LDA(dst, b, h) do { _Pragma("unroll") for (int m = 0; m < 4; ++m) _Pragma("unroll") for (int k = 0; k < 2; ++k) dst[m][k] = *(const PG8_LAS bf16x8*)(lds + PG8_SA(b, h) + aoff + m * 2048 + k * 1024); } while (0)
#define PG8_LDB(dst, b, h) do { _Pragma("unroll") for (int n = 0; n < 2; ++n) _Pragma("unroll") for (int k = 0; k < 2; ++k) dst[n][k] = *(const PG8_LAS bf16x8*)(lds + PG8_SB(b, h) + boff + n * 2048 + k * 1024); } while (0)
#define PG8_MMA(ai, bj, At, Bt) do { __builtin_amdgcn_s_setprio(1); _Pragma("unroll") for (int m = 0; m < 4; ++m) _Pragma("unroll") for (int n = 0; n < 2; ++n) _Pragma("unroll") for (int k = 0; k < 2; ++k) \
        acc[ai][bj][m][n] = __builtin_amdgcn_mfma_f32_16x16x32_bf16(Bt[n][k], At[m][k], acc[ai][bj][m][n], 0, 0, 0); __builtin_amdgcn_s_setprio(0); } while (0)
#define PG8_WAIT_V(n) asm volatile("s_waitcnt vmcnt(" #n ")" ::: "memory")
#define PG8_WAIT_L(n) asm volatile("s_waitcnt lgkmcnt(" #n ")" ::: "memory")
#define PG8_BAR __builtin_amdgcn_s_barrier()
#define PG8_SCHED __builtin_amdgcn_sched_barrier(0)
    Unit cur, nxt; int ui = 0;
    if (!S.next(0, cur)) return;
    f32x4 acc[2][2][4][2];
#pragma unroll
    for (int a = 0; a < 2; ++a)
#pragma unroll
        for (int b = 0; b < 2; ++b)
#pragma unroll
            for (int m = 0; m < 4; ++m)
#pragma unroll
                for (int n = 0; n < 2; ++n) acc[a][b][m][n] = (f32x4){0.f, 0.f, 0.f, 0.f};
    bf16x8 At[4][2], B0[2][2], B1[2][2];
    const char* cA = (const char*)g.A + (size_t)cur.pm * tstep; const char* cB = (const char*)g.Bt + (size_t)cur.pn * tstep;
    S.a_ready(cur);
    if constexpr (SP2) {
        PG8_STAGE(PG8_SB(0, 0), cB, voffB); PG8_STAGE(PG8_SB(0, 1), cB + hstep, voffB); PG8_STAGE(PG8_SA(0, 0), cA, voffA); PG8_STAGE(PG8_SA(0, 1), cA + hstep, voffA);
        if (wr == 1) PG8_BAR;
        PG8_WAIT_V(2); PG8_BAR;
        PG8_STAGE(PG8_SB(1, 0), cB + kstep, voffB); PG8_STAGE(PG8_SA(1, 0), cA + kstep, voffA); PG8_STAGE(PG8_SB(1, 1), cB + hstep + kstep, voffB);
        PG8_WAIT_V(6); PG8_BAR;
    } else {
        PG8_STAGE(PG8_SB(0, 0), cB, voffB); PG8_STAGE(PG8_SA(0, 0), cA, voffA); PG8_STAGE(PG8_SB(0, 1), cB + hstep, voffB); PG8_STAGE(PG8_SA(0, 1), cA + hstep, voffA);
        if (wr == 1) PG8_BAR;
        PG8_WAIT_V(4); PG8_BAR;
        PG8_STAGE(PG8_SB(1, 0), cB + kstep, voffB); PG8_STAGE(PG8_SA(1, 0), cA + kstep, voffA); PG8_STAGE(PG8_SB(1, 1), cB + hstep + kstep, voffB);
        PG8_WAIT_V(6); PG8_BAR;
    }
    for (;;) {
        const bool has_next = S.next(ui + 1, nxt);
        const char* nA = has_next ? (const char*)g.A + (size_t)nxt.pm * tstep : cA; const char* nB = has_next ? (const char*)g.Bt + (size_t)nxt.pn * tstep : cB;
        for (int t = 0; t < nt; t += 2) {
            const bool last = (t == nt - 2);
            const char* a1 = cA + (size_t)(t + 1) * kstep;
            const char* a2 = last ? nA : cA + (size_t)(t + 2) * kstep; const char* b2 = last ? nB : cB + (size_t)(t + 2) * kstep;
            const char* a3 = a2 + kstep; const char* b3 = b2 + kstep;
            if (last && has_next) S.a_ready(nxt);
            if constexpr (SP2) {
            PG8_LDB(B0, 0, 0); PG8_LDB(B1, 0, 1); PG8_SCHED; PG8_LDA(At, 0, 0); PG8_STAGE(PG8_SA(1, 1), a1 + hstep, voffA);
            PG8_WAIT_V(8); PG8_WAIT_L(0); PG8_BAR; PG8_MMA(0, 0, At, B0); PG8_MMA(0, 1, At, B1); PG8_BAR; PG8_SCHED;
            PG8_LDA(At, 0, 1); PG8_STAGE(PG8_SB(0, 0), b2, voffB); PG8_STAGE(PG8_SB(0, 1), b2 + hstep, voffB); PG8_STAGE(PG8_SA(0, 0), a2, voffA);
            PG8_WAIT_V(8); PG8_WAIT_L(0); PG8_BAR; PG8_MMA(1, 0, At, B0); PG8_MMA(1, 1, At, B1); PG8_BAR; PG8_SCHED;
            PG8_LDB(B0, 1, 0); PG8_LDB(B1, 1, 1); PG8_SCHED; PG8_LDA(At, 1, 0); PG8_STAGE(PG8_SA(0, 1), a2 + hstep, voffA);
            PG8_WAIT_V(8); PG8_WAIT_L(0); PG8_BAR; PG8_MMA(0, 0, At, B0); PG8_MMA(0, 1, At, B1); PG8_BAR; PG8_SCHED;
            PG8_LDA(At, 1, 1); PG8_STAGE(PG8_SB(1, 0), b3, voffB); PG8_STAGE(PG8_SB(1, 1), b3 + hstep, voffB); PG8_STAGE(PG8_SA(1, 0), a3, voffA);
            PG8_WAIT_V(8); PG8_WAIT_L(0); PG8_BAR; PG8_MMA(1, 0, At, B0); PG8_MMA(1, 1, At, B1); PG8_BAR; PG8_SCHED;
            } else {
            PG8_LDB(B0, 0, 0); PG8_SCHED; PG8_LDA(At, 0, 0); PG8_STAGE(PG8_SA(1, 1), a1 + hstep, voffA);
            PG8_WAIT_L(8); PG8_BAR; PG8_WAIT_L(0); PG8_MMA(0, 0, At, B0); PG8_BAR; PG8_SCHED;
            PG8_LDB(B1, 0, 1); PG8_STAGE(PG8_SB(0, 0), b2, voffB);
            PG8_BAR; PG8_WAIT_L(0); PG8_MMA(0, 1, At, B1); PG8_BAR;
            PG8_LDA(At, 0, 1); PG8_STAGE(PG8_SA(0, 0), a2, voffA);
            PG8_BAR; PG8_WAIT_L(0); PG8_MMA(1, 0, At, B0); PG8_BAR; PG8_SCHED;
            PG8_STAGE(PG8_SB(0, 1), b2 + hstep, voffB);
            PG8_WAIT_V(6); PG8_BAR; PG8_MMA(1, 1, At, B1); PG8_BAR;
            PG8_LDB(B0, 1, 0); PG8_SCHED; PG8_LDA(At, 1, 0); PG8_STAGE(PG8_SA(0, 1), a2 + hstep, voffA);
            PG8_WAIT_L(8); PG8_BAR; PG8_WAIT_L(0); PG8_MMA(0, 0, At, B0); PG8_BAR; PG8_SCHED;
            PG8_LDB(B1, 1, 1); PG8_STAGE(PG8_SB(1, 0), b3, voffB);
            PG8_BAR; PG8_WAIT_L(0); PG8_MMA(0, 1, At, B1); PG8_BAR;
            PG8_LDA(At, 1, 1); PG8_STAGE(PG8_SA(1, 0), a3, voffA);
            PG8_BAR; PG8_WAIT_L(0); PG8_MMA(1, 0, At, B0); PG8_BAR; PG8_SCHED;
            PG8_STAGE(PG8_SB(1, 1), b3 + hstep, voffB);
            PG8_WAIT_V(6); PG8_BAR; PG8_MMA(1, 1, At, B1); PG8_BAR;
            }
        }
        if constexpr (ALIGN_EPI) { if (wr == 0) PG8_BAR; }
        if constexpr (!Epi::AFTER_DRAIN) { E(acc, cur, wr, wc, fr, fq); S.done(cur); }
        if (!has_next) break;
#pragma unroll
        for (int a = 0; a < 2; ++a)
#pragma unroll
            for (int b = 0; b < 2; ++b)
#pragma unroll
                for (int m = 0; m < 4; ++m)
#pragma unroll
                    for (int n = 0; n < 2; ++n) acc[a][b][m][n] = (f32x4){0.f, 0.f, 0.f, 0.f};
        cur = nxt; cA = nA; cB = nB; ++ui;
        if constexpr (ALIGN_EPI) { if (wr == 1) PG8_BAR; }
    }
    PG8_WAIT_V(0);
    if constexpr (!ALIGN_EPI) { if (wr == 0) PG8_BAR; }
    PG8_BAR;
    if constexpr (Epi::AFTER_DRAIN) { E.fused(acc, cur, wr, wc, fr, fq, lds, wid, lane); S.done(cur); }
#undef PG8_SA
#undef PG8_SB
#undef PG8_STAGE
#undef PG8_LDA
#undef PG8_LDB
#undef PG8_MMA
#undef PG8_WAIT_V
#undef PG8_WAIT_L
#undef PG8_BAR
#undef PG8_SCHED
}
}
namespace pg8 {
struct EpiF32 {
    static constexpr bool PERM = false, AFTER_DRAIN = false;
    float* C; int ldc; const float* bias;
    __device__ __forceinline__ void operator()(const f32x4 (&acc)[2][2][4][2], const Unit& u, int wr, int wc, int fr, int fq) const {
        const int row0 = u.pm * BM + wr * 64 + fr, col0 = u.pn * BM + wc * 32 + 4 * fq;
        f32x4 bv[2][2];
#pragma unroll
        for (int bj = 0; bj < 2; ++bj)
#pragma unroll
            for (int n = 0; n < 2; ++n) bv[bj][n] = bias ? *(const f32x4*)(bias + col0 + bj * HALF + n * 16) : (f32x4){0.f, 0.f, 0.f, 0.f};
#pragma unroll
        for (int ai = 0; ai < 2; ++ai)
#pragma unroll
            for (int m = 0; m < 4; ++m) { float* rowp = C + (size_t)(row0 + ai * HALF + m * 16) * ldc + col0;
#pragma unroll
                for (int bj = 0; bj < 2; ++bj)
#pragma unroll
                    for (int n = 0; n < 2; ++n) *(f32x4*)(rowp + bj * HALF + n * 16) = acc[ai][bj][m][n] + bv[bj][n]; }
    }
};
}

#define LAS __attribute__((address_space(3)))
typedef unsigned short bf16;
typedef unsigned v4u __attribute__((ext_vector_type(4)));
typedef unsigned v2u __attribute__((ext_vector_type(2)));
typedef int v4i __attribute__((ext_vector_type(4)));
typedef float f32x4 __attribute__((ext_vector_type(4)));
typedef float f32x16 __attribute__((ext_vector_type(16)));
typedef short bf16x8 __attribute__((ext_vector_type(8)));

constexpr int SEQ = 16384, DM = 2048, DEPTH = 4, NMEM = 256, DFF = 4096;
constexpr int D_IN = 4646, NP1 = 4864;
constexpr int C_QA = 0, C_KA = 512, C_VA = 1024, C_QB = 1536, C_KB = 2304, C_VB = 3072, C_CQ = 3840, C_CKV = 4352, C_KR = 4608, C_FB = 4640;
constexpr int NQC = 768, NKVC = 1280;
constexpr int NTAB = 611, RELC = 305;
constexpr float EPS = 1e-6f;
constexpr float LOG2E = 1.4426950408889634f;

constexpr size_t MiB = 1u << 20;
constexpr size_t WS_CTL = 0, WS_TAB = 1 * MiB, WS_COS = 2 * MiB, WS_SIN = 3 * MiB, WS_KRR = 4 * MiB, WS_LOGF = 5 * MiB, WS_CUMF = 6 * MiB,
                 WS_KVX = 7 * MiB, WS_MEMN = 8 * MiB, WS_VTX = 9 * MiB, WS_WT = 16 * MiB;
constexpr size_t WT_IN = 0, WT_UQ = 19 * MiB, WT_UKV = 20 * MiB, WT_OUT = 21 * MiB, WT_QX = 29 * MiB, WT_KVX = 31 * MiB, WT_OX = 35 * MiB, WT_UP = 37 * MiB, WT_DOWN = 69 * MiB;
constexpr size_t WS_H = 104 * MiB, WS_Y = 168 * MiB, WS_O = 296 * MiB, WS_QX = 360 * MiB, WS_OX = 376 * MiB, WS_CQN = 392 * MiB, WS_CKVN = 408 * MiB,
                 WS_A = 416 * MiB, WS_PROJ = 544 * MiB, WS_QC = 696 * MiB, WS_KVC = 720 * MiB, WS_VTA = 760 * MiB, WS_VTB = 776 * MiB, WS_VTC = 800 * MiB,
                 WS_U = 544 * MiB, WS_END = 824 * MiB;
constexpr int LDS_BYTES = 147456;

struct Params {
    const float* x; const float* mem; const int* pos; const float* rel_bias; const float* w_in; const float* b_forget; const float* lam; const float* q_norm;
    const float* kv_norm; const float* w_uq; const float* w_ukv; const float* head_norm; const float* w_out; const float* norm_gains; const float* mem_norm;
    const float* wq_x; const float* wkv_x; const float* wo_x; const float* w_up; const float* conv_w; const float* conv_b; const float* w_down;
    float* out; unsigned char* ws;
    float lam_init[4];
    int stop_phase; int pad;
};

#define LDS_WAIT() asm volatile("s_waitcnt lgkmcnt(0)" ::: "memory")
__device__ __forceinline__ unsigned f2bf(float f) { unsigned u = __builtin_bit_cast(unsigned, f); return (u + 0x7fffu + ((u >> 16) & 1u)) >> 16; }
__device__ __forceinline__ unsigned pk2(float lo, float hi) { return f2bf(lo) | (f2bf(hi) << 16); }
__device__ __forceinline__ float bflo(unsigned w) { return __builtin_bit_cast(float, w << 16); }
__device__ __forceinline__ float bfhi(unsigned w) { return __builtin_bit_cast(float, w & 0xffff0000u); }
__device__ __forceinline__ float wave_sum(float v) {
#pragma unroll
    for (int o = 1; o < 64; o <<= 1) v += __shfl_xor(v, o);
    return v;
}
__device__ __forceinline__ float swap32f(float v) { auto rr = __builtin_amdgcn_permlane32_swap(__builtin_bit_cast(unsigned, v), __builtin_bit_cast(unsigned, v), false, false);
    return __builtin_bit_cast(float, (__lane_id() & 32) ? rr[0] : rr[1]); }

struct MapIn  { static constexpr bool VEC = false; __device__ __forceinline__ int operator()(int d) const { return d < 3840 ? d : (d < 4640 ? d + 6 : (d < 4646 ? d - 800 : -1)); } };
struct MapPad { static constexpr bool VEC = true; int N; __device__ __forceinline__ int operator()(int d) const { return d < N ? d : -1; } };
template <class Map> __device__ __forceinline__ void wt_item(const float* __restrict__ W, int K, int N, bf16* __restrict__ WT, LAS float* scr, int kb, int db, int lane, Map cmap) {
    const int k0 = 64 * kb, d0 = 32 * db;
    if constexpr (Map::VEC) {
        const int krow = lane >> 3, c4 = (lane & 7) * 4; const bool valid = (d0 + c4) < N;
        const float* src = W + (size_t)(k0 + krow) * N + d0 + c4;
#pragma unroll
        for (int i = 0; i < 8; ++i) { f32x4 v = {0.f, 0.f, 0.f, 0.f}; if (valid) v = *(const f32x4*)(src + (size_t)(8 * i) * N);
            LAS float* d = scr + (8 * i + krow) * 33 + c4; d[0] = v.x; d[1] = v.y; d[2] = v.z; d[3] = v.w; }
    } else {
    const int c = cmap(d0 + (lane & 31));
    const float* src = W + (size_t)(k0 + (lane >> 5)) * N + (c >= 0 ? c : 0);
#pragma unroll 8
    for (int i = 0; i < 32; ++i) { const float v = src[(size_t)(2 * i) * N]; scr[(2 * i + (lane >> 5)) * 33 + (lane & 31)] = c >= 0 ? v : 0.f; }
    }
    LDS_WAIT();
    const int ch = lane & 7;
#pragma unroll
    for (int j = 0; j < 4; ++j) { const int n = (lane >> 3) + 8 * j; const LAS float* s = scr + (8 * ch) * 33 + n;
        v4u o; o.x = pk2(s[0 * 33], s[1 * 33]); o.y = pk2(s[2 * 33], s[3 * 33]); o.z = pk2(s[4 * 33], s[5 * 33]); o.w = pk2(s[6 * 33], s[7 * 33]);
        *(v4u*)(WT + (size_t)(d0 + n) * K + k0 + 8 * ch) = o; }
    LDS_WAIT();
}
template <class Map> __device__ __forceinline__ void wt_matrix(const float* W, int K, int N, int Npad, bf16* WT, LAS float* scr, int& base, int gw, int NGW, int lane, Map cmap) {
    const int nd = Npad / 32, items = (K / 64) * nd;
    int first = (gw - base % NGW + NGW) % NGW;
    for (int it = first; it < items; it += NGW) wt_item(W, K, N, WT, scr, it / nd, it % nd, lane, cmap);
    base += items;
}

__device__ __forceinline__ void norm_row(const float* xin, const bf16* y, const float* gpost, const float* gpre, float* xout, bf16* hout, int lane) {
    f32x4 v[8];
#pragma unroll
    for (int j = 0; j < 8; ++j) v[j] = ((const f32x4*)xin)[lane + 64 * j];
    if (y) {
        f32x4 yy[8]; float ss = 0.f;
#pragma unroll
        for (int j = 0; j < 8; ++j) { const v2u yw = ((const v2u*)y)[lane + 64 * j]; yy[j] = (f32x4){bflo(yw.x), bfhi(yw.x), bflo(yw.y), bfhi(yw.y)}; ss += (yy[j].x * yy[j].x + yy[j].y * yy[j].y) + (yy[j].z * yy[j].z + yy[j].w * yy[j].w); }
        const float r = 1.0f / sqrtf(wave_sum(ss) * (1.0f / DM) + EPS);
#pragma unroll
        for (int j = 0; j < 8; ++j) { const f32x4 g = ((const f32x4*)gpost)[lane + 64 * j]; v[j] = v[j] + yy[j] * r * g; }
    }
    if (xout) {
#pragma unroll
        for (int j = 0; j < 8; ++j) ((f32x4*)xout)[lane + 64 * j] = v[j];
    }
    if (hout) {
        float ss = 0.f;
#pragma unroll
        for (int j = 0; j < 8; ++j) ss += (v[j].x * v[j].x + v[j].y * v[j].y) + (v[j].z * v[j].z + v[j].w * v[j].w);
        const float r = 1.0f / sqrtf(wave_sum(ss) * (1.0f / DM) + EPS);
#pragma unroll
        for (int j = 0; j < 8; ++j) { const f32x4 g = ((const f32x4*)gpre)[lane + 64 * j]; const f32x4 h = v[j] * r * g;
            v2u o; o.x = pk2(h.x, h.y); o.y = pk2(h.z, h.w); ((v2u*)hout)[lane + 64 * j] = o; }
    }
}

__device__ __forceinline__ void prep1_row(const Params& p, int layer, int t, int lane) {
    const bf16* row = (const bf16*)(p.ws + WS_PROJ) + (size_t)t * NP1;
    { const v4u w = *(const v4u*)(row + C_CQ + lane * 8);
      float f[8] = {bflo(w.x), bfhi(w.x), bflo(w.y), bfhi(w.y), bflo(w.z), bfhi(w.z), bflo(w.w), bfhi(w.w)};
      float ss = 0.f;
#pragma unroll
      for (int j = 0; j < 8; ++j) ss += f[j] * f[j];
      const float r = 1.0f / sqrtf(wave_sum(ss) * (1.0f / 512) + EPS);
      const float* g = p.q_norm + layer * 512 + lane * 8;
      v4u o; o.x = pk2(f[0] * r * g[0], f[1] * r * g[1]); o.y = pk2(f[2] * r * g[2], f[3] * r * g[3]); o.z = pk2(f[4] * r * g[4], f[5] * r * g[5]); o.w = pk2(f[6] * r * g[6], f[7] * r * g[7]);
      *(v4u*)((bf16*)(p.ws + WS_CQN) + (size_t)t * 512 + lane * 8) = o; }
    { const v2u w = *(const v2u*)(row + C_CKV + lane * 4);
      float f[4] = {bflo(w.x), bfhi(w.x), bflo(w.y), bfhi(w.y)};
      float ss = (f[0] * f[0] + f[1] * f[1]) + (f[2] * f[2] + f[3] * f[3]);
      const float r = 1.0f / sqrtf(wave_sum(ss) * (1.0f / 256) + EPS);
      const float* g = p.kv_norm + layer * 256 + lane * 4;
      v2u o; o.x = pk2(f[0] * r * g[0], f[1] * r * g[1]); o.y = pk2(f[2] * r * g[2], f[3] * r * g[3]);
      *(v2u*)((bf16*)(p.ws + WS_CKVN) + (size_t)t * 256 + lane * 4) = o; }
    if (lane < 16) {
        const float t1 = __builtin_bit_cast(float, (unsigned)row[C_KR + lane] << 16), t2 = __builtin_bit_cast(float, (unsigned)row[C_KR + 16 + lane] << 16);
        const float cs = ((const float*)(p.ws + WS_COS))[t * 16 + lane], sn = ((const float*)(p.ws + WS_SIN))[t * 16 + lane];
        bf16* kr = (bf16*)(p.ws + WS_KRR) + (size_t)t * 32;
        kr[lane] = (bf16)f2bf(t1 * cs - t2 * sn); kr[16 + lane] = (bf16)f2bf(t2 * cs + t1 * sn);
    } else if (lane < 22) {
        const int h = lane - 16;
        const float xv = __builtin_bit_cast(float, (unsigned)row[C_FB + h] << 16) + p.b_forget[layer * 6 + h];
        const float ls = fminf(xv, 0.f) - log1pf(expf(-fabsf(xv)));
        ((float*)(p.ws + WS_LOGF))[h * SEQ + t] = ls;
    }
}
__device__ __forceinline__ void prep1_qknorm(const bf16* row, int lane, float (&mq)[2], float (&mk)[2]) {
#pragma unroll
    for (int j = 0; j < 2; ++j) {
        float sq = 0.f, sk = 0.f;
        if (j == 0 || lane < 32) {
            const v4u a = *(const v4u*)(row + C_QB + j * 512 + lane * 8), b = *(const v4u*)(row + C_KB + j * 512 + lane * 8);
            float f[8]; f[0] = bflo(a.x); f[1] = bfhi(a.x); f[2] = bflo(a.y); f[3] = bfhi(a.y); f[4] = bflo(a.z); f[5] = bfhi(a.z); f[6] = bflo(a.w); f[7] = bfhi(a.w);
#pragma unroll
            for (int e = 0; e < 8; ++e) sq += f[e] * f[e];
            f[0] = bflo(b.x); f[1] = bfhi(b.x); f[2] = bflo(b.y); f[3] = bfhi(b.y); f[4] = bflo(b.z); f[5] = bfhi(b.z); f[6] = bflo(b.w); f[7] = bfhi(b.w);
#pragma unroll
            for (int e = 0; e < 8; ++e) sk += f[e] * f[e];
        }
#pragma unroll
        for (int o = 1; o < 16; o <<= 1) { sq += __shfl_xor(sq, o); sk += __shfl_xor(sk, o); }
        mq[j] = fmaxf(mq[j], sq); mk[j] = fmaxf(mk[j], sk);
    }
}
__device__ __forceinline__ void vt_item(const bf16* src, int src_stride, bf16* dst, int dst_stride, LAS unsigned short* scr, int lane) {
#pragma unroll
    for (int i = 0; i < 8; ++i) { const int r = i * 8 + (lane >> 3), ch = lane & 7; const v4u w = *(const v4u*)(src + (size_t)r * src_stride + ch * 8);
        LAS unsigned* d = (LAS unsigned*)(scr + r * 66 + ch * 8); d[0] = w.x; d[1] = w.y; d[2] = w.z; d[3] = w.w; }
    LDS_WAIT();
#pragma unroll
    for (int i = 0; i < 8; ++i) { const int c = i * 8 + (lane >> 3), ch = lane & 7; const LAS unsigned short* s = scr + (ch * 8) * 66 + c;
        v4u o; o.x = (unsigned)s[0] | ((unsigned)s[66] << 16); o.y = (unsigned)s[2 * 66] | ((unsigned)s[3 * 66] << 16); o.z = (unsigned)s[4 * 66] | ((unsigned)s[5 * 66] << 16); o.w = (unsigned)s[6 * 66] | ((unsigned)s[7 * 66] << 16);
        *(v4u*)(dst + (size_t)c * dst_stride + ch * 8) = o; }
    LDS_WAIT();
}

typedef short s16x4 __attribute__((ext_vector_type(4)));
#define KSWZ(row, colB) ((row) * 256 + ((colB) ^ (((row) & 7) << 4)))
#define SBAR() __builtin_amdgcn_sched_barrier(0)
constexpr int AT_SHM_V = 16384, AT_SHM_K = 16384;
constexpr int AT_V = 0, AT_K = 49152, AT_WS = 98304, AT_TAB = 100352, AT_WORD = 102912;
__device__ __forceinline__ int crow(int r, int hi) { return (r & 3) + 8 * (r >> 2) + 4 * hi; }
__device__ __forceinline__ unsigned cvtpk(float lo, float hi) { unsigned r; asm volatile("v_cvt_pk_bf16_f32 %0, %1, %2" : "=v"(r) : "v"(lo), "v"(hi)); return r; }

__device__ __forceinline__ void partialSM(f32x16& p0, f32x16& p1, float& m_reg, float& alpha, float C, float thr_u) {
    float pmax = p0[0];
#pragma unroll
    for (int r = 1; r < 16; ++r) pmax = fmaxf(pmax, p0[r]);
#pragma unroll
    for (int r = 0; r < 16; ++r) pmax = fmaxf(pmax, p1[r]);
    pmax = fmaxf(pmax, __shfl_xor(pmax, 32));
    float mn;
    if (__builtin_expect(__all(pmax - m_reg <= thr_u), 1)) { mn = m_reg; alpha = 1.f; }
    else { mn = fmaxf(m_reg, pmax); alpha = __builtin_amdgcn_exp2f((m_reg - mn) * C); m_reg = mn; }
    const float mnC = -mn * C;
#pragma unroll
    for (int r = 0; r < 16; ++r) p0[r] = __builtin_fmaf(p0[r], C, mnC);
#pragma unroll
    for (int r = 0; r < 16; ++r) p1[r] = __builtin_fmaf(p1[r], C, mnC);
#pragma unroll
    for (int r = 0; r < 16; ++r) p0[r] = __builtin_amdgcn_exp2f(p0[r]);
}
__device__ __forceinline__ void finishSM(f32x16& p0, f32x16& p1, float alpha, float& l_reg, bf16x8& pa0, bf16x8& pa1, bf16x8& pa2, bf16x8& pa3) {
#pragma unroll
    for (int r = 0; r < 16; ++r) p1[r] = __builtin_amdgcn_exp2f(p1[r]);
    float ps = 0;
#pragma unroll
    for (int r = 0; r < 16; ++r) ps += p0[r];
#pragma unroll
    for (int r = 0; r < 16; ++r) ps += p1[r];
    ps += __shfl_xor(ps, 32);
    l_reg = l_reg * alpha + ps;
#define PK4(P, BASE, OUT) do { unsigned a0 = cvtpk(P[BASE + 0], P[BASE + 1]), a1 = cvtpk(P[BASE + 2], P[BASE + 3]);   \
    unsigned b0 = cvtpk(P[BASE + 4], P[BASE + 5]), b1 = cvtpk(P[BASE + 6], P[BASE + 7]);                              \
    auto r0 = __builtin_amdgcn_permlane32_swap(a0, b0, false, false); auto r1 = __builtin_amdgcn_permlane32_swap(a1, b1, false, false); \
    v4u w_ = {r0[0], r1[0], r0[1], r1[1]}; OUT = __builtin_bit_cast(bf16x8, w_); } while (0)
    PK4(p0, 0, pa0); PK4(p0, 8, pa1); PK4(p1, 0, pa2); PK4(p1, 8, pa3);
#undef PK4
}
__device__ __forceinline__ int v_st(int k, int c) { const int kk = (k & ~0xC) | ((k & 4) << 1) | ((k & 8) >> 1); return ((kk >> 3) * 4 + (c >> 5)) * 512 + ((kk & 7) * 32 + (c & 31)) * 2; }
__device__ __forceinline__ int v_rd_base(int lane) { return ((lane & 3) << 3) | (((lane >> 2) & 3) << 6) | (((lane >> 4) & 1) << 5) | (((lane >> 5) & 1) << 8); }
constexpr int v_rd_off(int d0, int ks, int half) { return d0 * 512 + ks * 4096 + half * 2048; }
template <int OFF> __device__ __forceinline__ s16x4 tr_read(int vb) { s16x4 r; asm volatile("ds_read_b64_tr_b16 %0, %1 offset:%2" : "=&v"(r) : "v"(vb), "i"(OFF) : "memory"); return r; }
template <int D0> __device__ __forceinline__ void pv_one(f32x16& od, int vb, bf16x8 pa0, bf16x8 pa1, bf16x8 pa2, bf16x8 pa3) {
    const s16x4 l0 = tr_read<v_rd_off(D0, 0, 0)>(vb), h0 = tr_read<v_rd_off(D0, 0, 1)>(vb), l1 = tr_read<v_rd_off(D0, 1, 0)>(vb), h1 = tr_read<v_rd_off(D0, 1, 1)>(vb);
    const s16x4 l2 = tr_read<v_rd_off(D0, 2, 0)>(vb), h2 = tr_read<v_rd_off(D0, 2, 1)>(vb), l3 = tr_read<v_rd_off(D0, 3, 0)>(vb), h3 = tr_read<v_rd_off(D0, 3, 1)>(vb);
    asm volatile("s_waitcnt lgkmcnt(0)" ::: "memory"); SBAR();
#define PKV(L, H) (bf16x8){L[0], L[1], L[2], L[3], H[0], H[1], H[2], H[3]}
    od = __builtin_amdgcn_mfma_f32_32x32x16_bf16(pa0, PKV(l0, h0), od, 0, 0, 0);
    od = __builtin_amdgcn_mfma_f32_32x32x16_bf16(pa1, PKV(l1, h1), od, 0, 0, 0);
    od = __builtin_amdgcn_mfma_f32_32x32x16_bf16(pa2, PKV(l2, h2), od, 0, 0, 0);
    od = __builtin_amdgcn_mfma_f32_32x32x16_bf16(pa3, PKV(l3, h3), od, 0, 0, 0);
#undef PKV
}
__device__ __forceinline__ void pv_d0(f32x16 (&o)[4], int vb, bf16x8 pa0, bf16x8 pa1, bf16x8 pa2, bf16x8 pa3) {
    pv_one<0>(o[0], vb, pa0, pa1, pa2, pa3); pv_one<1>(o[1], vb, pa0, pa1, pa2, pa3); pv_one<2>(o[2], vb, pa0, pa1, pa2, pa3); pv_one<3>(o[3], vb, pa0, pa1, pa2, pa3);
}

template <int DK, int MODE>
__device__ __forceinline__ void attn_pass(LAS unsigned char* lds, const bf16* __restrict__ Qp, int qs, const bf16* __restrict__ Kp, int ks, const bf16* __restrict__ K2p,
                                          const bf16* __restrict__ Vp, int vs, int q0, int t_begin, int NT, float C,
                                          const float* __restrict__ cumF, const int* __restrict__ pos, const float* __restrict__ cosT, const float* __restrict__ sinT,
                                          const int* __restrict__ pmax64, f32x16 (&o)[4]) {
    const int tid = tid_opaque(), wid = __builtin_amdgcn_readfirstlane(tid >> 6), lane = tid & 63, r32 = lane & 31, hi = lane >> 5;
    const int qrow = q0 + wid * 32 + r32;
#ifdef DBG_THR0
    const float thr_u = 0.0f;
#else
    const float thr_u = 8.0f * LOG2E / C;
#endif
    LAS const float* tab = (LAS const float*)(lds + AT_TAB);
    LAS float* wsl = (LAS float*)(lds + AT_WS) + wid * 64; LAS float* li_l = wsl; LAS float* al_l = wsl + 32;
    float m_reg = -1e30f, l_reg = 0.f;
#pragma unroll
    for (int d = 0; d < 4; ++d)
#pragma unroll
        for (int i = 0; i < 16; ++i) o[d][i] = 0.f;
    bf16x8 qr[DK / 16];
#pragma unroll
    for (int kk = 0; kk < DK / 16; ++kk) qr[kk] = *(const bf16x8*)(Qp + (size_t)qrow * qs + kk * 16 + hi * 8);
    if constexpr (MODE == 2) {
        const float* cp = cosT + (size_t)qrow * 16 + hi * 8; const float* sp = sinT + (size_t)qrow * 16 + hi * 8;
        bf16x8 a = qr[4], b = qr[5];
#pragma unroll
        for (int j = 0; j < 8; ++j) { const float t1 = __builtin_bit_cast(float, (unsigned)(unsigned short)a[j] << 16), t2 = __builtin_bit_cast(float, (unsigned)(unsigned short)b[j] << 16);
            const float cs = cp[j], sn = sp[j]; a[j] = (short)f2bf(t1 * cs - t2 * sn); b[j] = (short)f2bf(t2 * cs + t1 * sn); }
        qr[4] = a; qr[5] = b;
    }
    int posq = 0, qpmin = 0; float FrefS = 0.f;
    if constexpr (MODE == 0) { posq = pos[qrow]; int mn = posq;
#pragma unroll
        for (int s = 1; s < 64; s <<= 1) mn = min(mn, __shfl_xor(mn, s));
        qpmin = mn; }
    if constexpr (MODE == 1) FrefS = cumF[q0] * 11.313708498984761f;
    const int cq = (MODE == 3) ? NT : ((q0 + wid * 32) >> 6);
    const int sr = tid >> 4, cidx = tid & 15, sc = cidx * 8, vst0 = v_st(sr, sc), vst1 = v_st(32 + sr, sc);
    const bool kact = cidx < DK / 8;
    const int vb0 = (int)(unsigned)(uintptr_t)(lds + AT_V) + v_rd_base(lane);
    bf16x8 sv0[1], sv1[1], sk0[1], sk1[1];
#define KPTR(row) ((MODE == 2 && cidx >= 8) ? K2p + (size_t)(row) * 32 + (cidx - 8) * 8 : Kp + (size_t)(row) * ks + sc)
#define SLOAD(i, t) do { const int k0_ = (t) * 64; sv0[i] = *(const bf16x8*)(Vp + (size_t)(k0_ + sr) * vs + sc); sv1[i] = *(const bf16x8*)(Vp + (size_t)(k0_ + 32 + sr) * vs + sc); \
        if (kact) { sk0[i] = *(const bf16x8*)KPTR(k0_ + sr); sk1[i] = *(const bf16x8*)KPTR(k0_ + 32 + sr); } } while (0)
#define SWRITE(b, i) do { *(LAS bf16x8*)(lds + AT_V + (b) * AT_SHM_V + vst0) = sv0[i]; *(LAS bf16x8*)(lds + AT_V + (b) * AT_SHM_V + vst1) = sv1[i]; \
        if (kact) { *(LAS bf16x8*)(lds + AT_K + (b) * AT_SHM_K + KSWZ(sr, sc * 2)) = sk0[i]; *(LAS bf16x8*)(lds + AT_K + (b) * AT_SHM_K + KSWZ(32 + sr, sc * 2)) = sk1[i]; } } while (0)
#define SWAIT4() asm volatile("s_waitcnt vmcnt(4)" ::: "memory")
#define RESC(a) do { if (__any((a) < 1.f)) { if (hi == 0) al_l[r32] = (a); asm volatile("s_waitcnt lgkmcnt(0)" ::: "memory"); \
        _Pragma("unroll") for (int d = 0; d < 4; ++d) _Pragma("unroll") for (int r = 0; r < 16; ++r) o[d][r] *= al_l[crow(r, hi)]; } } while (0)
    auto qkt = [&](f32x16& p0, f32x16& p1, int kb, int t) {
        if constexpr (MODE == 0) { const float ci = (pmax64[t] - qpmin > -RELC) ? 0.f : tab[0];
#pragma unroll
            for (int i = 0; i < 16; ++i) { p0[i] = ci; p1[i] = ci; } }
        else if constexpr (MODE == 1) { const float* fp = cumF + t * 64 + 4 * hi;
#pragma unroll
            for (int g = 0; g < 4; ++g) { const f32x4 a = *(const f32x4*)(fp + 8 * g), b = *(const f32x4*)(fp + 32 + 8 * g);
#pragma unroll
                for (int e = 0; e < 4; ++e) { p0[4 * g + e] = __builtin_fmaf(a[e], -11.313708498984761f, FrefS); p1[4 * g + e] = __builtin_fmaf(b[e], -11.313708498984761f, FrefS); } } }
        else {
#pragma unroll
            for (int i = 0; i < 16; ++i) { p0[i] = 0.f; p1[i] = 0.f; } }
        LAS const unsigned char* Ks = lds + AT_K + kb * AT_SHM_K;
#pragma unroll
        for (int d0 = 0; d0 < DK / 16; ++d0) { const int cb = (d0 * 16 + hi * 8) * 2;
            const bf16x8 b0 = *(LAS const bf16x8*)(Ks + KSWZ(r32, cb));
            const bf16x8 b1 = *(LAS const bf16x8*)(Ks + KSWZ(32 + r32, cb));
            p0 = __builtin_amdgcn_mfma_f32_32x32x16_bf16(b0, qr[d0], p0, 0, 0, 0);
            p1 = __builtin_amdgcn_mfma_f32_32x32x16_bf16(b1, qr[d0], p1, 0, 0, 0); }
    };
    auto post = [&](f32x16& p0, f32x16& p1, int t) {
        if constexpr (MODE == 0) {
            if (pmax64[t] - qpmin > -RELC) {
                const int* pp = pos + t * 64 + 4 * hi;
#pragma unroll
                for (int g = 0; g < 4; ++g) { const v4i a = *(const v4i*)(pp + 8 * g), b = *(const v4i*)(pp + 32 + 8 * g);
#pragma unroll
                    for (int e = 0; e < 4; ++e) { const int ra = min(max(a[e] - posq, -RELC), RELC) + RELC, rb = min(max(b[e] - posq, -RELC), RELC) + RELC;
                        p0[4 * g + e] += tab[ra]; p1[4 * g + e] += tab[rb]; } }
            }
        }
        if constexpr (MODE == 1) {
            if (t == cq) { const int kb0 = t * 64 + 4 * hi;
#pragma unroll
                for (int i = 0; i < 16; ++i) { const int kv = kb0 + (i & 3) + 8 * (i >> 2); if (kv > qrow) p0[i] = -1e30f; if (kv + 32 > qrow) p1[i] = -1e30f; } }
        }
    };
    int tdense_end = (MODE == 3) ? NT : (q0 >> 6);
    int nd = tdense_end - t_begin; nd &= ~1; if (nd < 2) nd = 0;
#ifdef DBG_NODENSE
    nd = 0;
#endif
    const int tb = t_begin;
    if (nd) {
        f32x16 pA0, pA1, pB0, pB1; float alA, alB; bf16x8 pa0, pa1, pa2, pa3;
        SLOAD(0, tb); asm volatile("s_waitcnt vmcnt(0)" ::: "memory"); SWRITE(0, 0); __syncthreads();
        qkt(pA0, pA1, 0, tb); post(pA0, pA1, tb); partialSM(pA0, pA1, m_reg, alA, C, thr_u);
        SLOAD(0, tb + 1);
        SWRITE(1, 0); __syncthreads();
        int bp = 0, bc = 1, bn = 2;
        for (int j = 1; j + 1 < nd; j += 2) {
            SBAR(); qkt(pB0, pB1, bc, tb + j);
            finishSM(pA0, pA1, alA, l_reg, pa0, pa1, pa2, pa3); SBAR();
            SLOAD(0, tb + j + 1); SBAR();
            pv_d0(o, vb0 + bp * AT_SHM_V, pa0, pa1, pa2, pa3); post(pB0, pB1, tb + j); partialSM(pB0, pB1, m_reg, alB, C, thr_u);
            SWRITE(bn, 0);
            RESC(alB); __syncthreads();
            { const int t_ = bp; bp = bc; bc = bn; bn = t_; }
            SBAR(); qkt(pA0, pA1, bc, tb + j + 1);
            finishSM(pB0, pB1, alB, l_reg, pa0, pa1, pa2, pa3); SBAR();
            SLOAD(0, tb + j + 2); SBAR();
            pv_d0(o, vb0 + bp * AT_SHM_V, pa0, pa1, pa2, pa3); post(pA0, pA1, tb + j + 1); partialSM(pA0, pA1, m_reg, alA, C, thr_u);
            SWRITE(bn, 0);
            RESC(alA); __syncthreads();
            { const int t_ = bp; bp = bc; bc = bn; bn = t_; }
        }
        SBAR(); qkt(pB0, pB1, bc, tb + nd - 1);
        finishSM(pA0, pA1, alA, l_reg, pa0, pa1, pa2, pa3); SBAR();
        pv_d0(o, vb0 + bp * AT_SHM_V, pa0, pa1, pa2, pa3); post(pB0, pB1, tb + nd - 1); partialSM(pB0, pB1, m_reg, alB, C, thr_u);
        RESC(alB);
        finishSM(pB0, pB1, alB, l_reg, pa0, pa1, pa2, pa3); SBAR();
        pv_d0(o, vb0 + bc * AT_SHM_V, pa0, pa1, pa2, pa3);
        __syncthreads();
    }
    for (int t = tb + nd; t < NT; ++t) {
        SLOAD(0, t); asm volatile("s_waitcnt vmcnt(0)" ::: "memory"); SWRITE(0, 0); __syncthreads();
        if (t <= cq) {
            f32x16 p0, p1; float al; bf16x8 pa0, pa1, pa2, pa3;
            qkt(p0, p1, 0, t); post(p0, p1, t); partialSM(p0, p1, m_reg, al, C, thr_u);
            finishSM(p0, p1, al, l_reg, pa0, pa1, pa2, pa3);
            RESC(al);
            pv_d0(o, vb0, pa0, pa1, pa2, pa3);
        }
        __syncthreads();
    }
    if (hi == 0) li_l[r32] = l_reg;
    asm volatile("s_waitcnt lgkmcnt(0)" ::: "memory");
#pragma unroll
    for (int r = 0; r < 16; ++r) {
#ifdef DBG_DIRECT
        const float rl = 1.0f / __shfl(l_reg, crow(r, hi));
#else
        const float rl = __builtin_amdgcn_rcpf(li_l[crow(r, hi)]);
#endif
#pragma unroll
        for (int d = 0; d < 4; ++d) o[d][r] *= rl; }
#undef KPTR
#undef SLOAD
#undef SWRITE
#undef SWAIT4
#undef RESC
}

__device__ __forceinline__ void attn_finish(LAS unsigned char* lds, f32x16 (&o)[4], bool do_rms, float rr_scale, const float* gain, bf16* obuf, int ostride, int q0, int col0) {
    const int tid = tid_opaque(), wid = __builtin_amdgcn_readfirstlane(tid >> 6), lane = tid & 63, r32 = lane & 31, hi = lane >> 5;
    float g4[4] = {1.f, 1.f, 1.f, 1.f};
    if (gain) {
#pragma unroll
        for (int d = 0; d < 4; ++d) g4[d] = gain[col0 + d * 32 + r32];
    }
#ifdef DBG_DIRECT
#pragma unroll
    for (int r = 0; r < 16; ++r) {
        float rr = rr_scale;
        if (do_rms) {
            float ss = (o[0][r] * o[0][r] + o[1][r] * o[1][r]) + (o[2][r] * o[2][r] + o[3][r] * o[3][r]);
#pragma unroll
            for (int s = 1; s < 32; s <<= 1) ss += __shfl_xor(ss, s);
            rr = rr_scale / sqrtf(ss * (1.0f / 128) + EPS);
        }
        const int row = crow(r, hi);
#pragma unroll
        for (int d = 0; d < 4; ++d) obuf[(size_t)(q0 + wid * 32 + row) * ostride + col0 + d * 32 + r32] = (unsigned short)f2bf(o[d][r] * rr * g4[d]);
    }
}
#else
    LAS unsigned short* stg = (LAS unsigned short*)(lds + wid * 8192);
#pragma unroll
    for (int r = 0; r < 16; ++r) {
        float rr = rr_scale;
        if (do_rms) {
            float ss = (o[0][r] * o[0][r] + o[1][r] * o[1][r]) + (o[2][r] * o[2][r] + o[3][r] * o[3][r]);
#pragma unroll
            for (int s = 1; s < 32; s <<= 1) ss += __shfl_xor(ss, s);
            rr = rr_scale / sqrtf(ss * (1.0f / 128) + EPS);
        }
        const int row = crow(r, hi);
#pragma unroll
        for (int d = 0; d < 4; ++d) stg[row * 128 + d * 32 + r32] = (unsigned short)f2bf(o[d][r] * rr * g4[d]);
    }
    LDS_WAIT();
#pragma unroll
    for (int i = 0; i < 8; ++i) { const int c = i * 64 + lane, row = c >> 4, ch = c & 15;
        const v4u v = *(LAS const v4u*)(stg + row * 128 + ch * 8);
        *(v4u*)(obuf + (size_t)(q0 + wid * 32 + row) * ostride + col0 + ch * 8) = v; }
    LDS_WAIT();
}
#endif

__device__ __forceinline__ void self_attn_A(const Params& p, LAS unsigned char* lds, int layer, int h, int qb) {
    const int tid = tid_opaque(), lane = tid & 63, wid = __builtin_amdgcn_readfirstlane(tid >> 6);
    const int q0 = qb * 256, NT = q0 / 64 + 4;
    const bf16* proj = (const bf16*)(p.ws + WS_PROJ);
    { LAS float* tab = (LAS float*)(lds + AT_TAB); const float* tg = (const float*)(p.ws + WS_TAB) + h * NTAB; for (int i = tid; i < NTAB; i += 512) tab[i] = tg[i]; }
    __syncthreads();
    unsigned* park = (unsigned*)(p.ws + WS_VTA) + ((size_t)(blockIdx.x * 8 + wid) * 64 + lane) * 32;
    for (int mp = 0; mp < 2; ++mp) {
        f32x16 o[4];
        attn_pass<64, 0>(lds, proj + C_QA + h * 128 + mp * 64, NP1, proj + C_KA + h * 128 + mp * 64, NP1, nullptr, proj + C_VA + h * 128, NP1, q0, 0, NT, 0.125f * LOG2E,
                         nullptr, p.pos, nullptr, nullptr, (const int*)(p.ws + WS_TAB + 16384), o);
        if (mp == 0) {
#pragma unroll
            for (int d = 0; d < 4; ++d)
#pragma unroll
                for (int r = 0; r < 8; ++r) park[d * 8 + r] = pk2(o[d][2 * r], o[d][2 * r + 1]);
        } else {
            const float* lm = p.lam + layer * 256;
            const float d01 = wave_sum(lm[lane] * lm[64 + lane]), d23 = wave_sum(lm[128 + lane] * lm[192 + lane]);
            const float li = p.lam_init[layer], lamv = expf(d01) - expf(d23) + li;
            LDS_WAIT();
#pragma unroll
            for (int d = 0; d < 4; ++d)
#pragma unroll
                for (int r = 0; r < 8; ++r) { const unsigned w = __hip_atomic_load(park + d * 8 + r, __ATOMIC_RELAXED, __HIP_MEMORY_SCOPE_AGENT); o[d][2 * r] = bflo(w) - lamv * o[d][2 * r]; o[d][2 * r + 1] = bfhi(w) - lamv * o[d][2 * r + 1]; }
            attn_finish(lds, o, true, 1.0f - li, p.head_norm + layer * 2048, (bf16*)(p.ws + WS_O), DM, q0, h * 128);
        }
    }
}
__device__ __forceinline__ void self_attn_B(const Params& p, LAS unsigned char* lds, int layer, int h, int qb) {
    const int tid = tid_opaque();
    const int q0 = qb * 256, NT = q0 / 64 + 4;
    const bf16* proj = (const bf16*)(p.ws + WS_PROJ);
    const float* cumF = (const float*)(p.ws + WS_CUMF) + (size_t)h * SEQ;
    int t_begin = 0;
    {
        LAS int* tbp = (LAS int*)(lds + AT_WORD + 64);
        if (tid == 0) *tbp = q0 / 64;
        __syncthreads();
        const unsigned* nb = (const unsigned*)(p.ws + WS_CTL) + 64 + layer * 16 + h * 2;
        const float B = 0.08838834764831845f * sqrtf(__builtin_bit_cast(float, nb[0]) * __builtin_bit_cast(float, nb[1]));
        const float Fq = cumF[q0];
        if (tid < q0 / 64) { const float bound = 2.0f * B + (Fq - cumF[tid * 64 + 63]) + 9.0f; if (bound >= -105.0f) __hip_atomic_fetch_min(tbp, tid, __ATOMIC_RELAXED, __HIP_MEMORY_SCOPE_WORKGROUP); }
        __syncthreads();
        t_begin = __builtin_amdgcn_readfirstlane(*tbp);
    }
    f32x16 o[4];
    attn_pass<128, 1>(lds, proj + C_QB + h * 128, NP1, proj + C_KB + h * 128, NP1, nullptr, proj + C_VB + h * 128, NP1, q0, t_begin, NT, 0.08838834764831845f * LOG2E,
                      cumF, nullptr, nullptr, nullptr, nullptr, o);
    attn_finish(lds, o, true, 1.0f, p.head_norm + layer * 2048, (bf16*)(p.ws + WS_O), DM, q0, 512 + h * 128);
}
__device__ __forceinline__ void self_attn_C(const Params& p, LAS unsigned char* lds, int layer, int h, int qb) {
    const int q0 = qb * 256, NT = q0 / 64 + 4;
    f32x16 o[4];
    attn_pass<96, 2>(lds, (const bf16*)(p.ws + WS_QC) + h * 96, NQC, (const bf16*)(p.ws + WS_KVC) + h * 192, NKVC, (const bf16*)(p.ws + WS_KRR), (const bf16*)(p.ws + WS_KVC) + h * 192 + 64, NKVC,
                     q0, 0, NT, 0.10206207261596575f * LOG2E, nullptr, nullptr, (const float*)(p.ws + WS_COS), (const float*)(p.ws + WS_SIN), nullptr, o);
    attn_finish(lds, o, true, 1.0f, p.head_norm + layer * 2048, (bf16*)(p.ws + WS_O), DM, q0, 1280 + h * 128);
}

__device__ __forceinline__ float gelu_tanh(float x) {
    const float z = 0.7978845608028654f * (x + 0.044715f * x * x * x);
    const float e = __builtin_amdgcn_exp2f(z * (2.0f * LOG2E));
    const float th = 1.0f - 2.0f * __builtin_amdgcn_rcpf(e + 1.0f);
    return 0.5f * x * (1.0f + th);
}
__device__ __forceinline__ void unpack8(const v4u w, float (&f)[8]) { f[0] = bflo(w.x); f[1] = bfhi(w.x); f[2] = bflo(w.y); f[3] = bfhi(w.y); f[4] = bflo(w.z); f[5] = bfhi(w.z); f[6] = bflo(w.w); f[7] = bfhi(w.w); }
__device__ __forceinline__ void convgate_task(const Params& p, int layer, int rs, int cgp) {
    const bf16* U = (const bf16*)(p.ws + WS_U); bf16* A = (bf16*)(p.ws + WS_A);
    const int j0 = cgp * 8, t0 = rs * 32;
    const float* cw = p.conv_w + (size_t)layer * 3 * 8192; const float* cb = p.conv_b + (size_t)layer * 8192;
    float wg[3][8], wv[3][8], bg[8], bv[8];
#pragma unroll
    for (int tp = 0; tp < 3; ++tp)
#pragma unroll
        for (int j = 0; j < 8; ++j) { wg[tp][j] = cw[tp * 8192 + j0 + j]; wv[tp][j] = cw[tp * 8192 + 4096 + j0 + j]; }
#pragma unroll
    for (int j = 0; j < 8; ++j) { bg[j] = cb[j0 + j]; bv[j] = cb[4096 + j0 + j]; }
    float g2[8], g1[8], v2[8], v1[8];
#pragma unroll
    for (int j = 0; j < 8; ++j) { g2[j] = g1[j] = v2[j] = v1[j] = 0.f; }
    if (t0 >= 2) {
        unpack8(*(const v4u*)(U + (size_t)(t0 - 2) * 8192 + j0), g2); unpack8(*(const v4u*)(U + (size_t)(t0 - 2) * 8192 + 4096 + j0), v2);
        unpack8(*(const v4u*)(U + (size_t)(t0 - 1) * 8192 + j0), g1); unpack8(*(const v4u*)(U + (size_t)(t0 - 1) * 8192 + 4096 + j0), v1);
    }
#pragma unroll 4
    for (int t = t0; t < t0 + 32; ++t) {
        float g0[8], v0[8];
        unpack8(*(const v4u*)(U + (size_t)t * 8192 + j0), g0); unpack8(*(const v4u*)(U + (size_t)t * 8192 + 4096 + j0), v0);
        float r[8];
#pragma unroll
        for (int j = 0; j < 8; ++j) {
            const float cgv = bg[j] + g2[j] * wg[0][j] + g1[j] * wg[1][j] + g0[j] * wg[2][j];
            const float cvv = bv[j] + v2[j] * wv[0][j] + v1[j] * wv[1][j] + v0[j] * wv[2][j];
            r[j] = gelu_tanh(cgv) * cvv;
            g2[j] = g1[j]; g1[j] = g0[j]; v2[j] = v1[j]; v1[j] = v0[j];
        }
        v4u o; o.x = pk2(r[0], r[1]); o.y = pk2(r[2], r[3]); o.z = pk2(r[4], r[5]); o.w = pk2(r[6], r[7]);
        *(v4u*)(A + (size_t)t * 4096 + j0) = o;
    }
}

constexpr int CW_BAR = 4096, MISC_OFF = 139264;
#define XB_TMO      128
#define XB_XCNT(j)  (256  + 64 * (j))
#define XB_XSUB(j)  (1280 + 64 * (j))
#define XB_XGEN(j)  (2304 + 64 * (j))
#define XB_TOP      3328
#define XB_TOPGEN   3392
#define XCD_BAR_WORDS 3456
#define XB_SPIN_CAP (1u << 18)

__device__ __forceinline__ unsigned xb_ld(unsigned* p)              { return __hip_atomic_load(p, __ATOMIC_RELAXED, __HIP_MEMORY_SCOPE_AGENT); }
__device__ __forceinline__ unsigned xb_add(unsigned* p, unsigned v) { return __hip_atomic_fetch_add(p, v, __ATOMIC_RELAXED, __HIP_MEMORY_SCOPE_AGENT); }
__device__ __forceinline__ unsigned xb_xcc_id() { return (unsigned)__builtin_amdgcn_s_getreg((3 << 11) | 20) & 0xFu; }
#define XB_SPIN(cond, bar) do { unsigned _sp = 0; while (cond) { __builtin_amdgcn_s_sleep(1); \
    if ((++_sp & 255u) == 0u) { if (xb_ld(&(bar)[XB_TMO])) break; if (_sp > XB_SPIN_CAP) { atomicAdd(&(bar)[XB_TMO], 1u); break; } } } } while (0)

struct XcdBarrier {
    unsigned* bar; unsigned x;
    volatile LAS unsigned* st;
};

__device__ __forceinline__ XcdBarrier xcd_barrier_post(unsigned* bar, volatile LAS unsigned* st) {
    XcdBarrier b; b.bar = bar; b.x = xb_xcc_id(); b.st = st;
    if (threadIdx.x == 0) (void)xb_add(&bar[XB_XCNT(b.x)], 1u);
    return b;
}
__device__ __forceinline__ void xcd_barrier_complete(unsigned* bar, unsigned x, unsigned& nloc, unsigned& nx) {
    const unsigned G = gridDim.x * gridDim.y * gridDim.z;
    unsigned sum, cnt, mine, sp = 0u;
    for (;;) {
        sum = 0u; cnt = 0u; mine = 0u;
#pragma unroll
        for (unsigned j = 0; j < 16; ++j) { const unsigned c = xb_ld(&bar[XB_XCNT(j)]); sum += c; cnt += (c > 0u) ? 1u : 0u; mine = (j == x) ? c : mine; }
        if (sum == G) break;
        __builtin_amdgcn_s_sleep(1);
        if ((++sp & 255u) == 0u) { if (xb_ld(&bar[XB_TMO])) break; if (sp > XB_SPIN_CAP) { atomicAdd(&bar[XB_TMO], 1u); break; } }
    }
    nloc = mine > 0u ? mine : 1u; nx = cnt > 0u ? cnt : 1u;
}

__device__ __forceinline__ void xcd_barrier(const XcdBarrier& b) {
    asm volatile("s_waitcnt vmcnt(0)" ::: "memory");
    __syncthreads();
    if (threadIdx.x == 0) {
        unsigned* bar = b.bar;
        __builtin_amdgcn_s_waitcnt(0);
        unsigned nloc = b.st[0], nx = b.st[1];
        if (nloc == 0u) { xcd_barrier_complete(bar, b.x, nloc, nx); b.st[0] = nloc; b.st[1] = nx; }
        const unsigned old = xb_add(&bar[XB_XSUB(b.x)], 1u);
        const unsigned gen = old / nloc;
        if (old + 1u == (gen + 1u) * nloc) {
            __builtin_amdgcn_fence(__ATOMIC_RELEASE, "agent");
            asm volatile("s_waitcnt vmcnt(0)" ::: "memory");
            const unsigned og = xb_add(&bar[XB_TOP], 1u);
            const unsigned tg = og / nx;
            if (og + 1u == (tg + 1u) * nx) xb_add(&bar[XB_TOPGEN], 1u);
            else XB_SPIN(xb_ld(&bar[XB_TOPGEN]) == tg, bar);
            __builtin_amdgcn_fence(__ATOMIC_ACQUIRE, "agent");
            xb_add(&bar[XB_XGEN(b.x)], 1u);
            asm volatile("s_waitcnt vmcnt(0)" ::: "memory");
        } else {
            XB_SPIN(xb_ld(&bar[XB_XGEN(b.x)]) == gen, bar);
            __builtin_amdgcn_fence(__ATOMIC_ACQUIRE, "agent");
            asm volatile("s_waitcnt vmcnt(0)" ::: "memory");
        }
    }
    __syncthreads();
}

struct GemmJob { const bf16* A; const bf16* Bt; void* C; int M, N, K, ldc, f32, cshift; };
__device__ __forceinline__ GemmJob gemm_job(unsigned char* ws, int id) {
    GemmJob J;
    switch (id) {
    case 0:  J = GemmJob{(const bf16*)(ws + WS_H),    (const bf16*)(ws + WS_WT + WT_IN),   ws + WS_PROJ, SEQ,  NP1,  DM,  NP1,  0, 0};  break;
    case 1:  J = GemmJob{(const bf16*)(ws + WS_MEMN), (const bf16*)(ws + WS_WT + WT_KVX),  ws + WS_KVX,  NMEM, 1024, DM,  1024, 0, 64}; break;
    case 2:  J = GemmJob{(const bf16*)(ws + WS_CQN),  (const bf16*)(ws + WS_WT + WT_UQ),   ws + WS_QC,   SEQ,  NQC,  512, NQC,  0, 0};  break;
    case 3:  J = GemmJob{(const bf16*)(ws + WS_CKVN), (const bf16*)(ws + WS_WT + WT_UKV),  ws + WS_KVC,  SEQ,  NKVC, 256, NKVC, 0, 64}; break;
    case 4:  J = GemmJob{(const bf16*)(ws + WS_O),    (const bf16*)(ws + WS_WT + WT_OUT),  ws + WS_Y,    SEQ,  DM,   DM,  DM,   0, 0};  break;
    case 5:  J = GemmJob{(const bf16*)(ws + WS_H),    (const bf16*)(ws + WS_WT + WT_QX),   ws + WS_QX,   SEQ,  512,  DM,  512,  0, 0};  break;
    case 6:  J = GemmJob{(const bf16*)(ws + WS_OX),   (const bf16*)(ws + WS_WT + WT_OX),   ws + WS_Y,    SEQ,  DM,   512, DM,   0, 0};  break;
    case 7:  J = GemmJob{(const bf16*)(ws + WS_H),    (const bf16*)(ws + WS_WT + WT_UP),   ws + WS_U,    SEQ,  8192, DM,  8192, 0, 0};  break;
    default: J = GemmJob{(const bf16*)(ws + WS_A),    (const bf16*)(ws + WS_WT + WT_DOWN), ws + WS_Y,    SEQ,  DM,   DFF, DM,   0, 0};  break;
    }
    return J;
}

__global__ void __launch_bounds__(512, 2) mega_fwd(Params p_unused) {
    extern __shared__ __attribute__((aligned(16))) unsigned char lds_raw[];
    LAS unsigned char* lds = (LAS unsigned char*)lds_raw;
    cg::grid_group grid = cg::this_grid();
    const Params* pp0 = (const Params*)__builtin_amdgcn_kernarg_segment_ptr();
    const int G = gridDim.x, bx = blockIdx.x, NGW = G * 8;
    {
    const Params* pp = pp0; asm volatile("" : "+s"(pp));
    const Params& p = *pp;
    const int tid = tid_opaque();
    unsigned char* ws = p.ws;
    unsigned* ctl = (unsigned*)(ws + WS_CTL);
    {
        if (bx == 0) for (int i = tid; i < CW_BAR + XCD_BAR_WORDS; i += 512) ctl[i] = 0u;
        if (tid < 2) ((LAS unsigned*)(lds + MISC_OFF))[tid] = 0u;
        const int gt = bx * 512 + tid, NT_ = G * 512;
        for (int i = gt; i < SEQ * 16; i += NT_) {
            const int t = i >> 4, k = i & 15;
            const float inv = (float)exp(-(double)(2 * k) / 32.0 * 9.210340371976184);
            const float ang = (float)p.pos[t] * inv;
            const double xd = (double)ang, kq = rint(xd * 0.6366197723675814), r = (xd - kq * 1.5707963267948966) - kq * 6.123233995736766e-17, r2 = r * r;
            const double sn = r * (1.0 + r2 * (-1.0 / 6 + r2 * (1.0 / 120 + r2 * (-1.0 / 5040 + r2 * (1.0 / 362880 - r2 / 39916800)))));
            const double cs = 1.0 + r2 * (-0.5 + r2 * (1.0 / 24 + r2 * (-1.0 / 720 + r2 * (1.0 / 40320 + r2 * (-1.0 / 3628800 + r2 / 479001600)))));
            const int q = (int)((long long)kq & 3);
            const double s_ = (q == 0) ? sn : (q == 1) ? cs : (q == 2) ? -sn : -cs, c_ = (q == 0) ? cs : (q == 1) ? -sn : (q == 2) ? -cs : sn;
            ((float*)(ws + WS_COS))[i] = (float)c_; ((float*)(ws + WS_SIN))[i] = (float)s_;
        }
        for (int i = gt; i < 4 * NTAB; i += NT_) {
            const int h = i / NTAB, rel = i % NTAB - RELC, n = rel < 0 ? -rel : rel;
            const float nf = (float)(n > 1 ? n : 1);
            int large = 8 + (int)(logf(nf / 8.0f) / 4.1588830833596715f * 8.0f); large = large < 15 ? large : 15;
            const int bucket = (rel > 0 ? 16 : 0) + (n < 8 ? n : large);
            ((float*)(ws + WS_TAB))[i] = p.rel_bias[bucket * 4 + h] * 8.0f;
        }
        for (int i = gt; i < SEQ / 64; i += NT_) { int mx = p.pos[i * 64]; for (int j = 1; j < 64; ++j) mx = max(mx, p.pos[i * 64 + j]); ((int*)(ws + WS_TAB + 16384))[i] = mx; }
    }
    }

    constexpr int NSTEP = 14;
    for (int step = 0; step <= DEPTH * NSTEP; ++step) {
        const Params* pp = pp0; asm volatile("" : "+s"(pp));
        const Params& p = *pp;
        const int tid = tid_opaque();
        const int lane = tid & 63, wave = __builtin_amdgcn_readfirstlane(tid >> 6), gw = bx * 8 + wave;
        unsigned char* ws = p.ws;
        unsigned* ctl = (unsigned*)(ws + WS_CTL);
        const int layer = step / NSTEP, k = step - layer * NSTEP;
        int job0 = 0, njob = 0;
        switch (k) {
        case 0: {
#ifndef NO_WN
            if (layer < DEPTH) {
                LAS float* scr = (LAS float*)(lds + wave * 16384);
                int base = 0;
                wt_matrix(p.w_in + (size_t)layer * DM * D_IN, DM, D_IN, NP1, (bf16*)(ws + WS_WT + WT_IN), scr, base, gw, NGW, lane, MapIn{});
                wt_matrix(p.w_uq + (size_t)layer * 512 * 576, 512, 576, NQC, (bf16*)(ws + WS_WT + WT_UQ), scr, base, gw, NGW, lane, MapPad{576});
                wt_matrix(p.w_ukv + (size_t)layer * 256 * 1152, 256, 1152, NKVC, (bf16*)(ws + WS_WT + WT_UKV), scr, base, gw, NGW, lane, MapPad{1152});
                wt_matrix(p.w_out + (size_t)layer * DM * DM, DM, DM, DM, (bf16*)(ws + WS_WT + WT_OUT), scr, base, gw, NGW, lane, MapPad{DM});
                wt_matrix(p.wq_x + (size_t)layer * DM * 512, DM, 512, 512, (bf16*)(ws + WS_WT + WT_QX), scr, base, gw, NGW, lane, MapPad{512});
                wt_matrix(p.wkv_x + (size_t)layer * DM * 1024, DM, 1024, 1024, (bf16*)(ws + WS_WT + WT_KVX), scr, base, gw, NGW, lane, MapPad{1024});
                wt_matrix(p.wo_x + (size_t)layer * 512 * DM, 512, DM, DM, (bf16*)(ws + WS_WT + WT_OX), scr, base, gw, NGW, lane, MapPad{DM});
                wt_matrix(p.w_up + (size_t)layer * DM * 8192, DM, 8192, 8192, (bf16*)(ws + WS_WT + WT_UP), scr, base, gw, NGW, lane, MapPad{8192});
                wt_matrix(p.w_down + (size_t)layer * DFF * DM, DFF, DM, DM, (bf16*)(ws + WS_WT + WT_DOWN), scr, base, gw, NGW, lane, MapPad{DM});
                for (int r = gw; r < NMEM; r += NGW) norm_row(p.mem + (size_t)r * DM, nullptr, nullptr, p.mem_norm + (size_t)layer * DM, nullptr, (bf16*)(ws + WS_MEMN) + (size_t)r * DM, lane);
            }
#endif
        }
        case 6: case 10: {
            const float* xin = (step == 0) ? p.x : p.out;
            const bf16* y = (step == 0) ? nullptr : (const bf16*)(ws + WS_Y);
            const float* gpost = (k == 0) ? p.norm_gains + (size_t)((layer > 0 ? layer - 1 : 0) * 6 + 5) * DM : p.norm_gains + (size_t)(layer * 6 + (k == 6 ? 1 : 3)) * DM;
            const float* gpre = (layer < DEPTH) ? p.norm_gains + (size_t)(layer * 6 + (k == 0 ? 0 : (k == 6 ? 2 : 4))) * DM : nullptr;
            for (int r = gw; r < SEQ; r += NGW)
                norm_row(xin + (size_t)r * DM, y ? y + (size_t)r * DM : nullptr, gpost, gpre, p.out + (size_t)r * DM, gpre ? (bf16*)(ws + WS_H) + (size_t)r * DM : nullptr, lane);
        } break;
        case 1: job0 = 0; njob = 2; break;
        case 2: {
#ifndef NO_PREP1
            { float mq[2] = {0.f, 0.f}, mk[2] = {0.f, 0.f};
              for (int t = gw; t < SEQ; t += NGW) { prep1_row(p, layer, t, lane); prep1_qknorm((const bf16*)(ws + WS_PROJ) + (size_t)t * NP1, lane, mq, mk); }
              if ((lane & 15) == 0) { const int g = lane >> 4;
                  atomicMax(&ctl[64 + layer * 16 + g * 2], __builtin_bit_cast(unsigned, mq[0])); atomicMax(&ctl[64 + layer * 16 + g * 2 + 1], __builtin_bit_cast(unsigned, mk[0]));
                  if (g < 2) { atomicMax(&ctl[64 + layer * 16 + (4 + g) * 2], __builtin_bit_cast(unsigned, mq[1])); atomicMax(&ctl[64 + layer * 16 + (4 + g) * 2 + 1], __builtin_bit_cast(unsigned, mk[1])); } } }
#endif
        } break;
        case 3: {
#ifndef NO_PREP1
            if (bx >= 192 && bx < 198) {
                const float* lf = (const float*)(ws + WS_LOGF) + (size_t)(bx - 192) * SEQ + tid * 32; float* cf = (float*)(ws + WS_CUMF) + (size_t)(bx - 192) * SEQ + tid * 32;
                f32x4 v[8]; double loc = 0.0;
#pragma unroll
                for (int j = 0; j < 8; ++j) { v[j] = ((const f32x4*)lf)[j]; loc += ((double)v[j].x + (double)v[j].y) + ((double)v[j].z + (double)v[j].w); }
                double inc = loc;
#pragma unroll
                for (int o = 1; o < 64; o <<= 1) { const double n = __shfl_up(inc, o); if (lane >= o) inc += n; }
                LAS double* wt = (LAS double*)(lds + 131072);
                if (lane == 63) wt[wave] = inc;
                __syncthreads();
                double off = inc - loc;
                for (int kk = 0; kk < wave; ++kk) off += wt[kk];
                __syncthreads();
#pragma unroll
                for (int j = 0; j < 8; ++j) { f32x4 o; off += (double)v[j].x; o.x = (float)off; off += (double)v[j].y; o.y = (float)off; off += (double)v[j].z; o.z = (float)off; off += (double)v[j].w; o.w = (float)off; ((f32x4*)cf)[j] = o; }
            }
#endif
            job0 = 2; njob = 2;
        } break;
        case 4: {
#ifndef NO_ATTN
            LAS volatile unsigned* word = (LAS volatile unsigned*)(lds + AT_WORD);
#ifdef PROBE_ATTN2
            for (int rep = 0; rep < 2; ++rep) { if (rep) grid.sync();
#else
            { const int rep = 0;
#endif
            for (;;) {
                if (tid == 0) *word = atomicAdd(&ctl[layer + 8 * rep], 1u);
                __syncthreads();
                const int idx = __builtin_amdgcn_readfirstlane((int)*word);
                __syncthreads();
                if (idx >= 1024) break;
                if (idx < 640) { const int qb = 63 - idx / 10, j = idx % 10;
#ifdef ONLY_MODE
                    if (ONLY_MODE == 0) self_attn_A(p, lds, layer, j & 3, qb); else if (ONLY_MODE == 2) self_attn_C(p, lds, layer, j % 6, qb); else self_attn_B(p, lds, layer, j % 6, qb); continue;
#endif
                    if (j < 4) self_attn_A(p, lds, layer, j, qb); else self_attn_C(p, lds, layer, j - 4, qb); }
                else { const int r = idx - 640; self_attn_B(p, lds, layer, r % 6, 63 - r / 6); }
            }
            }
#endif
        } break;
        case 5: job0 = 4; njob = 1; break;
        case 7: job0 = 5; njob = 1; break;
        case 8: {
#ifndef NO_XATTN
            for (int u = bx; u < 256; u += G) {
                const int h = u & 3, qb = u >> 2, q0 = qb * 256;
                f32x16 o[4];
                attn_pass<128, 3>(lds, (const bf16*)(ws + WS_QX) + h * 128, 512, (const bf16*)(ws + WS_KVX) + h * 128, 1024, nullptr, (const bf16*)(ws + WS_KVX) + 512 + h * 128, 1024, q0, 0, 4,
                                  0.08838834764831845f * LOG2E, nullptr, nullptr, nullptr, nullptr, nullptr, o);
                attn_finish(lds, o, false, 1.0f, nullptr, (bf16*)(ws + WS_OX), 512, q0, h * 128);
                __syncthreads();
            }
#endif
        } break;
        case 9: job0 = 6; njob = 1; break;
        case 11: job0 = 7; njob = 1; break;
        case 12: {
#ifndef NO_CONV
            for (int task = bx * 512 + tid; task < 512 * 512; task += G * 512) convgate_task(p, layer, task >> 9, task & 511);
#endif
        } break;
        default: job0 = 8; njob = 1; break;
        }
#ifndef NO_GEMM
#ifdef PROBE_GEMM2
        for (int jj2 = 0; jj2 < 2 * njob; ++jj2) { const int jj = jj2 % njob;
#else
        for (int jj = 0; jj < njob; ++jj) {
#endif
            const GemmJob J = gemm_job(ws, job0 + jj);
            pg8::Gemm g{J.A, J.Bt, J.M, J.N, J.K}; pg8::StaticOrder S; S.init(J.M, J.N, G, (bx + J.cshift) % G);
            if (J.f32) { pg8::EpiF32 E{(float*)J.C, J.ldc, nullptr}; pg8::gemm_phase<pg8::EpiF32, pg8::StaticOrder, true, true>(lds, g, S, E); }
            else { pg8::EpiBf16<0> E{(bf16*)J.C, J.ldc, nullptr, 0, 0, 1.f}; pg8::gemm_phase<pg8::EpiBf16<0>, pg8::StaticOrder, true, true>(lds, g, S, E); }
        }
#endif
        if (step == DEPTH * NSTEP) break;
        if (step == 0) { grid.sync(); (void)xcd_barrier_post(ctl + CW_BAR, (volatile LAS unsigned*)(lds + MISC_OFF)); }
        else { XcdBarrier b; b.bar = ctl + CW_BAR; b.x = xb_xcc_id(); b.st = (volatile LAS unsigned*)(lds + MISC_OFF); xcd_barrier(b); }
        { const Params* pq = pp0; asm volatile("" : "+s"(pq)); if (pq->stop_phase && step + 1 >= pq->stop_phase) return; }
    }
}

extern "C" void kernel_launch(void* const* d_in, const int* in_sizes, int n_in, void* d_out, int out_size, void* d_ws, size_t ws_size, hipStream_t stream) {
    static int grid = 0;
    if (grid == 0) {
        if (n_in != 22 || out_size != SEQ * DM || ws_size < WS_END) { fprintf(stderr, "kernel_launch: unexpected shapes (n_in %d, out %d, ws %zu < %zu)\n", n_in, out_size, ws_size, (size_t)WS_END); grid = -1; return; }
        int dev = 0, cus = 0, per_cu = 0;
        if (hipGetDevice(&dev) != hipSuccess || hipDeviceGetAttribute(&cus, hipDeviceAttributeMultiprocessorCount, dev) != hipSuccess) { fprintf(stderr, "kernel_launch: device query failed\n"); grid = -1; return; }
        if (hipFuncSetAttribute((const void*)mega_fwd, hipFuncAttributeMaxDynamicSharedMemorySize, LDS_BYTES) != hipSuccess) { fprintf(stderr, "kernel_launch: hipFuncSetAttribute failed\n"); grid = -1; return; }
        if (hipOccupancyMaxActiveBlocksPerMultiprocessor(&per_cu, (const void*)mega_fwd, 512, LDS_BYTES) != hipSuccess || per_cu < 1) { fprintf(stderr, "kernel_launch: occupancy query says %d blocks per CU\n", per_cu); (void)hipGetLastError(); per_cu = 1; }
        grid = cus * (per_cu > 1 ? 1 : per_cu);
        fprintf(stderr, "kernel_launch: grid %d (cus %d, per_cu %d)\n", grid, cus, per_cu);
    }
    if (grid < 0) return;
    Params p{};
    p.x = (const float*)d_in[0]; p.mem = (const float*)d_in[1]; p.pos = (const int*)d_in[2]; p.rel_bias = (const float*)d_in[3]; p.w_in = (const float*)d_in[4];
    p.b_forget = (const float*)d_in[5]; p.lam = (const float*)d_in[6]; p.q_norm = (const float*)d_in[7]; p.kv_norm = (const float*)d_in[8]; p.w_uq = (const float*)d_in[9];
    p.w_ukv = (const float*)d_in[10]; p.head_norm = (const float*)d_in[11]; p.w_out = (const float*)d_in[12]; p.norm_gains = (const float*)d_in[13]; p.mem_norm = (const float*)d_in[14];
    p.wq_x = (const float*)d_in[15]; p.wkv_x = (const float*)d_in[16]; p.wo_x = (const float*)d_in[17]; p.w_up = (const float*)d_in[18]; p.conv_w = (const float*)d_in[19];
    p.conv_b = (const float*)d_in[20]; p.w_down = (const float*)d_in[21];
    p.out = (float*)d_out; p.ws = (unsigned char*)d_ws;
    for (int i = 0; i < 4; ++i) p.lam_init[i] = (float)(0.8 - 0.6 * exp(-0.3 * i));
    p.stop_phase = 0; p.pad = 0;
    void* args[] = {&p};
    hipError_t e = hipLaunchCooperativeKernel((const void*)mega_fwd, dim3(grid), dim3(512), args, LDS_BYTES, stream);
    if (e != hipSuccess) fprintf(stderr, "kernel_launch: cooperative launch failed: %s (grid %d)\n", hipGetErrorString(e), grid);
}
```

```cpp
#include <hip/hip_runtime.h>
#include <hip/hip_cooperative_groups.h>
#include <cstdio>
#include <cstdint>
namespace cg = cooperative_groups;
__device__ __forceinline__ int tid_opaque() { int t = threadIdx.x; asm volatile("" : "+v"(t)); return t; }
namespace pg8 {
#define PG8_LAS __attribute__((address_space(3)))
typedef unsigned short bf16_t;
typedef short bf16x8 __attribute__((ext_vector_type(8)));
typedef float f32x4 __attribute__((ext_vector_type(4)));
typedef unsigned u32x4 __attribute__((ext_vector_type(4)));
constexpr int BM = 256, BK = 64, HALF = 128, HTB = HALF * BK * 2  , STAGE_BYTES = 8 * HTB, NXCD = 8, WGM = 8;

__host__ __device__ __forceinline__ int lds_byte(int r, int c) { const int st = (r >> 4) * 2 + (c >> 5), rr = r & 15, cc = c & 31, ob = rr * 64 + cc * 2; return st * 1024 + (ob ^ (((ob >> 9) & 1) << 5)); }
__host__ __device__ __forceinline__ void stage_rc(int b, int& R, int& C) { const int st = b / 1024, sb = b % 1024, swz = sb ^ (((sb >> 9) & 1) << 5); R = (st >> 1) * 16 + swz / 64; C = (st & 1) * 32 + (swz % 64) / 2; }
__host__ __device__ __forceinline__ int perm32(int rho) { const int n = rho >> 4, i = rho & 15; return 8 * (i >> 2) + 4 * n + (i & 3); }

struct Unit { int pm, pn; };
struct Gemm { const bf16_t* A; const bf16_t* Bt; int M, N, K; };

struct StaticOrder {
    int nM, nN, nwg, G, c;
    __host__ __device__ void init(int M, int N, int G_, int c_) { nM = M / BM; nN = N / BM; nwg = nM * nN; G = G_; c = c_; }
    __host__ __device__ bool next(int i, Unit& u) const {
        const long L = (long)i * G + c; if (L >= nwg) return false;
        int wgid = (int)L; { const int q = nwg / NXCD, r = nwg % NXCD, xcd = wgid % NXCD, off = wgid / NXCD; wgid = (xcd < r ? xcd * (q + 1) : r * (q + 1) + (xcd - r) * q) + off; }
        const int nig = WGM * nN, gid = wgid / nig, fm = gid * WGM, gsz = (nM - fm) < WGM ? (nM - fm) : WGM;
        u.pm = fm + ((wgid % nig) % gsz); u.pn = (wgid % nig) / gsz; return true;
    }
    __device__ __forceinline__ void a_ready(const Unit&) const {}
    __device__ __forceinline__ void done(const Unit&) const {}
};

__device__ __forceinline__ unsigned cvt_pk_bf16(float lo, float hi) { unsigned r; asm volatile("v_cvt_pk_bf16_f32 %0, %1, %2" : "=v"(r) : "v"(lo), "v"(hi)); return r; }
typedef float f32x2 __attribute__((ext_vector_type(2)));
__device__ __forceinline__ f32x2 gelu_pk(f32x2 v) {
    const f32x2 av = __builtin_elementwise_abs(v), d = av * 0.2316418882f + 1.0f;
    f32x2 t; t.x = __builtin_amdgcn_rcpf(d.x); t.y = __builtin_amdgcn_rcpf(d.y);
    f32x2 q = t * 0.5307027145f + (-0.7265760135f); q = q * t + 0.7107068705f; q = q * t + (-0.142248368f); q = q * t + 0.127414796f; q = q * t;
    const f32x2 s = (v * v) * (-0.72134752044f);
    f32x2 e; e.x = __builtin_amdgcn_exp2f(s.x); e.y = __builtin_amdgcn_exp2f(s.y);
    const f32x2 m = v * (q * e), r = v - m;
    f32x2 o; o.x = v.x < 0.f ? m.x : r.x; o.y = v.y < 0.f ? m.y : r.y; return o;
}

template <int ACT  > struct EpiBf16 {
    static constexpr bool PERM = true, AFTER_DRAIN = false; static_assert(ACT == 0 || ACT == 1, "EpiBf16: ACT is 0 (none) or 1 (gelu_pk)");
    bf16_t* O; int ldc; const float* bias; int split_cols; size_t split_stride; float scale0;
    __device__ __forceinline__ void operator()(const f32x4 (&acc)[2][2][4][2], const Unit& u, int wr, int wc, int fr, int fq) const {
        const int row0 = u.pm * BM + wr * 64 + fr; int colt = u.pn * BM; bf16_t* base = O;
        float sc = 1.f; if (split_cols) { const int t = colt / split_cols; base += (size_t)t * split_stride; colt -= t * split_cols; if (t == 0) sc = scale0; }
        const int col0 = colt + wc * 32 + 8 * fq, bcol0 = u.pn * BM + wc * 32 + 8 * fq;
        f32x4 bv[2][2];
#pragma unroll
        for (int bj = 0; bj < 2; ++bj)
#pragma unroll
            for (int n = 0; n < 2; ++n) bv[bj][n] = bias ? *(const f32x4*)(bias + bcol0 + bj * HALF + 4 * n) : (f32x4){0.f, 0.f, 0.f, 0.f};
#pragma unroll
        for (int ai = 0; ai < 2; ++ai)
#pragma unroll
            for (int m = 0; m < 4; ++m) { bf16_t* rowp = base + (size_t)(row0 + ai * HALF + m * 16) * ldc + col0;
#pragma unroll
                for (int bj = 0; bj < 2; ++bj) { f32x4 v0 = acc[ai][bj][m][0] + bv[bj][0], v1 = acc[ai][bj][m][1] + bv[bj][1];
                    if (ACT == 1) { f32x2 a = gelu_pk((f32x2){v0[0], v0[1]}), b = gelu_pk((f32x2){v0[2], v0[3]}), c = gelu_pk((f32x2){v1[0], v1[1]}), d = gelu_pk((f32x2){v1[2], v1[3]});
                        v0 = (f32x4){a.x, a.y, b.x, b.y}; v1 = (f32x4){c.x, c.y, d.x, d.y}; }
                    v0 = v0 * sc; v1 = v1 * sc; u32x4 w; w.x = cvt_pk_bf16(v0[0], v0[1]); w.y = cvt_pk_bf16(v0[2], v0[3]); w.z = cvt_pk_bf16(v1[0], v1[1]); w.w = cvt_pk_bf16(v1[2], v1[3]);
                    *(u32x4*)(rowp + bj * HALF) = w; } }
    }
};


template <class Epi, class Sched, bool ALIGN_EPI = false, bool SP2 = false>
__device__ __forceinline__ void gemm_phase(PG8_LAS unsigned char* lds, const Gemm g, const Sched& S, const Epi& E) {
    const int tid = tid_opaque(), wid = __builtin_amdgcn_readfirstlane(tid >> 6), lane = tid & 63, wr = wid >> 2, wc = wid & 3, fr = lane & 15, fq = lane >> 4;
    const int K = g.K, nt = K / BK;
    unsigned voffA[2], voffB[2];
#pragma unroll
    for (int i = 0; i < 2; ++i) { int R, C; stage_rc(tid * 16 + i * 8192, R, C); const int Rb = Epi::PERM ? ((R & ~31) + perm32(R & 31)) : R;
        voffA[i] = (unsigned)(R * K + C) * 2u; voffB[i] = (unsigned)(Rb * K + C) * 2u; }
    const size_t kstep = (size_t)(BK * 2);
    const size_t hstep = (size_t)HALF * K * 2;
    const size_t tstep = 2 * hstep;
    const unsigned ldsw = (unsigned)wid * 1024u;
    const int aoff = lds_byte(wr * 64 + fr, fq * 8), boff = lds_byte(wc * 32 + fr, fq * 8);
#define PG8_SA(b, h) (((b) * 2 + (h)) * HTB)
#define PG8_SB(b, h) ((4 + (b) * 2 + (h)) * HTB)
#define PG8_STAGE(bufoff, gbase, voff) do { _Pragma("unroll") for (int _i = 0; _i < 2; ++_i) \
        __builtin_amdgcn_global_load_lds((const unsigned*)((const char*)(gbase) + (voff)[_i]), (PG8_LAS unsigned*)(lds + (bufoff) + ldsw + _i * 8192), 16, 0, 0); } while (0)
#define PG8_LDA(dst, b, h) do { _Pragma("unroll") for (int m = 0; m < 4; ++m) _Pragma("unroll") for (int k = 0; k < 2; ++k) dst[m][k] = *(const PG8_LAS bf16x8*)(lds + PG8_SA(b, h) + aoff + m * 2048 + k * 1024); } while (0)
#define PG8_LDB(dst, b, h) do { _Pragma("unroll") for (int n = 0; n < 2; ++n) _Pragma("unroll") for (int k = 0; k < 2; ++k) dst[n][k] = *(const PG8_LAS bf16x8*)(lds + PG8_SB(b, h) + boff + n * 2048 + k * 1024); } while (0)
#define PG8_MMA(ai, bj, At, Bt) do { __builtin_amdgcn_s_setprio(1); _Pragma("unroll") for (int m = 0; m < 4; ++m) _Pragma("unroll") for (int n = 0; n < 2; ++n) _Pragma("unroll") for (int k = 0; k < 2; ++k) \
        acc[ai][bj][m][n] = __builtin_amdgcn_mfma_f32_16x16x32_bf16(Bt[n][k], At[m][k], acc[ai][bj][m][n], 0, 0, 0); __builtin_amdgcn_s_setprio(0); } while (0)
#define PG8_WAIT_V(n) asm volatile("s_waitcnt vmcnt(" #n ")" ::: "memory")
#define PG8_WAIT_L(n) asm volatile("s_waitcnt lgkmcnt(" #n ")" ::: "memory")
#define PG8_BAR __builtin_amdgcn_s_barrier()
#define PG8_SCHED __builtin_amdgcn_sched_barrier(0)
    Unit cur, nxt; int ui = 0;
    if (!S.next(0, cur)) return;
    f32x4 acc[2][2][4][2];
#pragma unroll
    for (int a = 0; a < 2; ++a)
#pragma unroll
        for (int b = 0; b < 2; ++b)
#pragma unroll
            for (int m = 0; m < 4; ++m)
#pragma unroll
                for (int n = 0; n < 2; ++n) acc[a][b][m][n] = (f32x4){0.f, 0.f, 0.f, 0.f};
    bf16x8 At[4][2], B0[2][2], B1[2][2];
    const char* cA = (const char*)g.A + (size_t)cur.pm * tstep; const char* cB = (const char*)g.Bt + (size_t)cur.pn * tstep;
    S.a_ready(cur);
    if constexpr (SP2) {
        PG8_STAGE(PG8_SB(0, 0), cB, voffB); PG8_STAGE(PG8_SB(0, 1), cB + hstep, voffB); PG8_STAGE(PG8_SA(0, 0), cA, voffA); PG8_STAGE(PG8_SA(0, 1), cA + hstep, voffA);
        if (wr == 1) PG8_BAR;
        PG8_WAIT_V(2); PG8_BAR;
        PG8_STAGE(PG8_SB(1, 0), cB + kstep, voffB); PG8_STAGE(PG8_SA(1, 0), cA + kstep, voffA); PG8_STAGE(PG8_SB(1, 1), cB + hstep + kstep, voffB);
        PG8_WAIT_V(6); PG8_BAR;
    } else {
        PG8_STAGE(PG8_SB(0, 0), cB, voffB); PG8_STAGE(PG8_SA(0, 0), cA, voffA); PG8_STAGE(PG8_SB(0, 1), cB + hstep, voffB); PG8_STAGE(PG8_SA(0, 1), cA + hstep, voffA);
        if (wr == 1) PG8_BAR;
        PG8_WAIT_V(4); PG8_BAR;
        PG8_STAGE(PG8_SB(1, 0), cB + kstep, voffB); PG8_STAGE(PG8_SA(1, 0), cA + kstep, voffA); PG8_STAGE(PG8_SB(1, 1), cB + hstep + kstep, voffB);
        PG8_WAIT_V(6); PG8_BAR;
    }
    for (;;) {
        const bool has_next = S.next(ui + 1, nxt);
        const char* nA = has_next ? (const char*)g.A + (size_t)nxt.pm * tstep : cA; const char* nB = has_next ? (const char*)g.Bt + (size_t)nxt.pn * tstep : cB;
        for (int t = 0; t < nt; t += 2) {
            const bool last = (t == nt - 2);
            const char* a1 = cA + (size_t)(t + 1) * kstep;
            const char* a2 = last ? nA : cA + (size_t)(t + 2) * kstep; const char* b2 = last ? nB : cB + (size_t)(t + 2) * kstep;
            const char* a3 = a2 + kstep; const char* b3 = b2 + kstep;
            if (last && has_next) S.a_ready(nxt);
            if constexpr (SP2) {
            PG8_LDB(B0, 0, 0); PG8_LDB(B1, 0, 1); PG8_SCHED; PG8_LDA(At, 0, 0); PG8_STAGE(PG8_SA(1, 1), a1 + hstep, voffA);
            PG8_WAIT_V(8); PG8_WAIT_L(0); PG8_BAR; PG8_MMA(0, 0, At, B0); PG8_MMA(0, 1, At, B1); PG8_BAR; PG8_SCHED;
            PG8_LDA(At, 0, 1); PG8_STAGE(PG8_SB(0, 0), b2, voffB); PG8_STAGE(PG8_SB(0, 1), b2 + hstep, voffB); PG8_STAGE(PG8_SA(0, 0), a2, voffA);
            PG8_WAIT_V(8); PG8_WAIT_L(0); PG8_BAR; PG8_MMA(1, 0, At, B0); PG8_MMA(1, 1, At, B1); PG8_BAR; PG8_SCHED;
            PG8_LDB(B0, 1, 0); PG8_LDB(B1, 1, 1); PG8_SCHED; PG8_LDA(At, 1, 0); PG8_STAGE(PG8_SA(0, 1), a2 + hstep, voffA);
            PG8_WAIT_V(8); PG8_WAIT_L(0); PG8_BAR; PG8_MMA(0, 0, At, B0); PG8_MMA(0, 1, At, B1); PG8_BAR; PG8_SCHED;
            PG8_LDA(At, 1, 1); PG8_STAGE(PG8_SB(1, 0), b3, voffB); PG8_STAGE(PG8_SB(1, 1), b3 + hstep, voffB); PG8_STAGE(PG8_SA(1, 0), a3, voffA);
            PG8_WAIT_V(8); PG8_WAIT_L(0); PG8_BAR; PG8_MMA(1, 0, At, B0); PG8_MMA(1, 1, At, B1); PG8_BAR; PG8_SCHED;
            } else {
            PG8_LDB(B0, 0, 0); PG8_SCHED; PG8_LDA(At, 0, 0); PG8_STAGE(PG8_SA(1, 1), a1 + hstep, voffA);
            PG8_WAIT_L(8); PG8_BAR; PG8_WAIT_L(0); PG8_MMA(0, 0, At, B0); PG8_BAR; PG8_SCHED;
            PG8_LDB(B1, 0, 1); PG8_STAGE(PG8_SB(0, 0), b2, voffB);
            PG8_BAR; PG8_WAIT_L(0); PG8_MMA(0, 1, At, B1); PG8_BAR;
            PG8_LDA(At, 0, 1); PG8_STAGE(PG8_SA(0, 0), a2, voffA);
            PG8_BAR; PG8_WAIT_L(0); PG8_MMA(1, 0, At, B0); PG8_BAR; PG8_SCHED;
            PG8_STAGE(PG8_SB(0, 1), b2 + hstep, voffB);
            PG8_WAIT_V(6); PG8_BAR; PG8_MMA(1, 1, At, B1); PG8_BAR;
            PG8_LDB(B0, 1, 0); PG8_SCHED; PG8_LDA(At, 1, 0); PG8_STAGE(PG8_SA(0, 1), a2 + hstep, voffA);
            PG8_WAIT_L(8); PG8_BAR; PG8_WAIT_L(0); PG8_MMA(0, 0, At, B0); PG8_BAR; PG8_SCHED;
            PG8_LDB(B1, 1, 1); PG8_STAGE(PG8_SB(1, 0), b3, voffB);
            PG8_BAR; PG8_WAIT_L(0); PG8_MMA(0, 1, At, B1); PG8_BAR;
            PG8_LDA(At, 1, 1); PG8_STAGE(PG8_SA(1, 0), a3, voffA);
            PG8_BAR; PG8_WAIT_L(0); PG8_MMA(1, 0, At, B0); PG8_BAR; PG8_SCHED;
            PG8_STAGE(PG8_SB(1, 1), b3 + hstep, voffB);
            PG8_WAIT_V(6); PG8_BAR; PG8_MMA(1, 1, At, B1); PG8_BAR;
            }
        }
        if constexpr (ALIGN_EPI) { if (wr == 0) PG8_BAR; }
        if constexpr (!Epi::AFTER_DRAIN) { E(acc, cur, wr, wc, fr, fq); S.done(cur); }
        if (!has_next) break;
#pragma unroll
        for (int a = 0; a < 2; ++a)
#pragma unroll
            for (int b = 0; b < 2; ++b)
#pragma unroll
                for (int m = 0; m < 4; ++m)
#pragma unroll
                    for (int n = 0; n < 2; ++n) acc[a][b][m][n] = (f32x4){0.f, 0.f, 0.f, 0.f};
        cur = nxt; cA = nA; cB = nB; ++ui;
        if constexpr (ALIGN_EPI) { if (wr == 1) PG8_BAR; }
    }
    PG8_WAIT_V(0);
    if constexpr (!ALIGN_EPI) { if (wr == 0) PG8_BAR; }
    PG8_BAR;
    if constexpr (Epi::AFTER_DRAIN) { E.fused(acc, cur, wr, wc, fr, fq, lds, wid, lane); S.done(cur); }
#undef PG8_SA
#undef PG8_SB
#undef PG8_STAGE
#undef PG8_LDA
#undef PG8_LDB
#undef PG8_MMA
#undef PG8_WAIT_V
#undef PG8_WAIT_L
#undef PG8_BAR
#undef PG8_SCHED
}
}
namespace pg8 {
struct EpiF32 {
    static constexpr bool PERM = false, AFTER_DRAIN = false;
    float* C; int ldc; const float* bias;
    __device__ __forceinline__ void operator()(const f32x4 (&acc)[2][2][4][2], const Unit& u, int wr, int wc, int fr, int fq) const {
        const int row0 = u.pm * BM + wr * 64 + fr, col0 = u.pn * BM + wc * 32 + 4 * fq;
        f32x4 bv[2][2];
#pragma unroll
        for (int bj = 0; bj < 2; ++bj)
#pragma unroll
            for (int n = 0; n < 2; ++n) bv[bj][n] = bias ? *(const f32x4*)(bias + col0 + bj * HALF + n * 16) : (f32x4){0.f, 0.f, 0.f, 0.f};
#pragma unroll
        for (int ai = 0; ai < 2; ++ai)
#pragma unroll
            for (int m = 0; m < 4; ++m) { float* rowp = C + (size_t)(row0 + ai * HALF + m * 16) * ldc + col0;
#pragma unroll
                for (int bj = 0; bj < 2; ++bj)
#pragma unroll
                    for (int n = 0; n < 2; ++n) *(f32x4*)(rowp + bj * HALF + n * 16) = acc[ai][bj][m][n] + bv[bj][n]; }
    }
};
}

#define LAS __attribute__((address_space(3)))
typedef unsigned short bf16;
typedef unsigned v4u __attribute__((ext_vector_type(4)));
typedef unsigned v2u __attribute__((ext_vector_type(2)));
typedef int v4i __attribute__((ext_vector_type(4)));
typedef float f32x4 __attribute__((ext_vector_type(4)));
typedef float f32x16 __attribute__((ext_vector_type(16)));
typedef short bf16x8 __attribute__((ext_vector_type(8)));

constexpr int SEQ = 16384, DM = 2048, DEPTH = 4, NMEM = 256, DFF = 4096;
constexpr int D_IN = 4646, NP1 = 4864;
constexpr int C_QA = 0, C_KA = 512, C_VA = 1024, C_QB = 1536, C_KB = 2304, C_VB = 3072, C_CQ = 3840, C_CKV = 4352, C_KR = 4608, C_FB = 4640;
constexpr int NQC = 768, NKVC = 1280;
constexpr int NTAB = 611, RELC = 305;
constexpr float EPS = 1e-6f;
constexpr float LOG2E = 1.4426950408889634f;

constexpr size_t MiB = 1u << 20;
constexpr size_t WS_CTL = 0, WS_TAB = 1 * MiB, WS_COS = 2 * MiB, WS_SIN = 3 * MiB, WS_KRR = 4 * MiB, WS_LOGF = 5 * MiB, WS_CUMF = 6 * MiB,
                 WS_KVX = 7 * MiB, WS_MEMN = 8 * MiB, WS_VTX = 9 * MiB, WS_WT = 16 * MiB;
constexpr size_t WT_IN = 0, WT_UQ = 19 * MiB, WT_UKV = 20 * MiB, WT_OUT = 21 * MiB, WT_QX = 29 * MiB, WT_KVX = 31 * MiB, WT_OX = 35 * MiB, WT_UP = 37 * MiB, WT_DOWN = 69 * MiB;
constexpr size_t WS_H = 104 * MiB, WS_Y = 168 * MiB, WS_O = 296 * MiB, WS_QX = 360 * MiB, WS_OX = 376 * MiB, WS_CQN = 392 * MiB, WS_CKVN = 408 * MiB,
                 WS_A = 416 * MiB, WS_PROJ = 544 * MiB, WS_QC = 696 * MiB, WS_KVC = 720 * MiB, WS_VTA = 760 * MiB, WS_VTB = 776 * MiB, WS_VTC = 800 * MiB,
                 WS_U = 544 * MiB, WS_END = 824 * MiB;
constexpr int LDS_BYTES = 147456;

struct Params {
    const float* x; const float* mem; const int* pos; const float* rel_bias; const float* w_in; const float* b_forget; const float* lam; const float* q_norm;
    const float* kv_norm; const float* w_uq; const float* w_ukv; const float* head_norm; const float* w_out; const float* norm_gains; const float* mem_norm;
    const float* wq_x; const float* wkv_x; const float* wo_x; const float* w_up; const float* conv_w; const float* conv_b; const float* w_down;
    float* out; unsigned char* ws;
    float lam_init[4];
    int stop_phase; int pad;
};

#define LDS_WAIT() asm volatile("s_waitcnt lgkmcnt(0)" ::: "memory")
__device__ __forceinline__ unsigned f2bf(float f) { unsigned u = __builtin_bit_cast(unsigned, f); return (u + 0x7fffu + ((u >> 16) & 1u)) >> 16; }
__device__ __forceinline__ unsigned pk2(float lo, float hi) { return f2bf(lo) | (f2bf(hi) << 16); }
__device__ __forceinline__ float bflo(unsigned w) { return __builtin_bit_cast(float, w << 16); }
__device__ __forceinline__ float bfhi(unsigned w) { return __builtin_bit_cast(float, w & 0xffff0000u); }
__device__ __forceinline__ float wave_sum(float v) {
#pragma unroll
    for (int o = 1; o < 64; o <<= 1) v += __shfl_xor(v, o);
    return v;
}
__device__ __forceinline__ float swap32f(float v) { auto rr = __builtin_amdgcn_permlane32_swap(__builtin_bit_cast(unsigned, v), __builtin_bit_cast(unsigned, v), false, false);
    return __builtin_bit_cast(float, (__lane_id() & 32) ? rr[0] : rr[1]); }

struct MapIn  { static constexpr bool VEC = false; __device__ __forceinline__ int operator()(int d) const { return d < 3840 ? d : (d < 4640 ? d + 6 : (d < 4646 ? d - 800 : -1)); } };
struct MapPad { static constexpr bool VEC = true; int N; __device__ __forceinline__ int operator()(int d) const { return d < N ? d : -1; } };
template <class Map> __device__ __forceinline__ void wt_item(const float* __restrict__ W, int K, int N, bf16* __restrict__ WT, LAS float* scr, int kb, int db, int lane, Map cmap) {
    const int k0 = 64 * kb, d0 = 32 * db;
    if constexpr (Map::VEC) {
        const int krow = lane >> 3, c4 = (lane & 7) * 4; const bool valid = (d0 + c4) < N;
        const float* src = W + (size_t)(k0 + krow) * N + d0 + c4;
#pragma unroll
        for (int i = 0; i < 8; ++i) { f32x4 v = {0.f, 0.f, 0.f, 0.f}; if (valid) v = *(const f32x4*)(src + (size_t)(8 * i) * N);
            LAS float* d = scr + (8 * i + krow) * 33 + c4; d[0] = v.x; d[1] = v.y; d[2] = v.z; d[3] = v.w; }
    } else {
    const int c = cmap(d0 + (lane & 31));
    const float* src = W + (size_t)(k0 + (lane >> 5)) * N + (c >= 0 ? c : 0);
#pragma unroll 8
    for (int i = 0; i < 32; ++i) { const float v = src[(size_t)(2 * i) * N]; scr[(2 * i + (lane >> 5)) * 33 + (lane & 31)] = c >= 0 ? v : 0.f; }
    }
    LDS_WAIT();
    const int ch = lane & 7;
#pragma unroll
    for (int j = 0; j < 4; ++j) { const int n = (lane >> 3) + 8 * j; const LAS float* s = scr + (8 * ch) * 33 + n;
        v4u o; o.x = pk2(s[0 * 33], s[1 * 33]); o.y = pk2(s[2 * 33], s[3 * 33]); o.z = pk2(s[4 * 33], s[5 * 33]); o.w = pk2(s[6 * 33], s[7 * 33]);
        *(v4u*)(WT + (size_t)(d0 + n) * K + k0 + 8 * ch) = o; }
    LDS_WAIT();
}
template <class Map> __device__ __forceinline__ void wt_matrix(const float* W, int K, int N, int Npad, bf16* WT, LAS float* scr, int& base, int gw, int NGW, int lane, Map cmap) {
    const int nd = Npad / 32, items = (K / 64) * nd;
    int first = (gw - base % NGW + NGW) % NGW;
    for (int it = first; it < items; it += NGW) wt_item(W, K, N, WT, scr, it / nd, it % nd, lane, cmap);
    base += items;
}

__device__ __forceinline__ void norm_row(const float* xin, const bf16* y, const float* gpost, const float* gpre, float* xout, bf16* hout, int lane) {
    f32x4 v[8];
#pragma unroll
    for (int j = 0; j < 8; ++j) v[j] = ((const f32x4*)xin)[lane + 64 * j];
    if (y) {
        f32x4 yy[8]; float ss = 0.f;
#pragma unroll
        for (int j = 0; j < 8; ++j) { const v2u yw = ((const v2u*)y)[lane + 64 * j]; yy[j] = (f32x4){bflo(yw.x), bfhi(yw.x), bflo(yw.y), bfhi(yw.y)}; ss += (yy[j].x * yy[j].x + yy[j].y * yy[j].y) + (yy[j].z * yy[j].z + yy[j].w * yy[j].w); }
        const float r = 1.0f / sqrtf(wave_sum(ss) * (1.0f / DM) + EPS);
#pragma unroll
        for (int j = 0; j < 8; ++j) { const f32x4 g = ((const f32x4*)gpost)[lane + 64 * j]; v[j] = v[j] + yy[j] * r * g; }
    }
    if (xout) {
#pragma unroll
        for (int j = 0; j < 8; ++j) ((f32x4*)xout)[lane + 64 * j] = v[j];
    }
    if (hout) {
        float ss = 0.f;
#pragma unroll
        for (int j = 0; j < 8; ++j) ss += (v[j].x * v[j].x + v[j].y * v[j].y) + (v[j].z * v[j].z + v[j].w * v[j].w);
        const float r = 1.0f / sqrtf(wave_sum(ss) * (1.0f / DM) + EPS);
#pragma unroll
        for (int j = 0; j < 8; ++j) { const f32x4 g = ((const f32x4*)gpre)[lane + 64 * j]; const f32x4 h = v[j] * r * g;
            v2u o; o.x = pk2(h.x, h.y); o.y = pk2(h.z, h.w); ((v2u*)hout)[lane + 64 * j] = o; }
    }
}

__device__ __forceinline__ void prep1_row(const Params& p, int layer, int t, int lane) {
    const bf16* row = (const bf16*)(p.ws + WS_PROJ) + (size_t)t * NP1;
    { const v4u w = *(const v4u*)(row + C_CQ + lane * 8);
      float f[8] = {bflo(w.x), bfhi(w.x), bflo(w.y), bfhi(w.y), bflo(w.z), bfhi(w.z), bflo(w.w), bfhi(w.w)};
      float ss = 0.f;
#pragma unroll
      for (int j = 0; j < 8; ++j) ss += f[j] * f[j];
      const float r = 1.0f / sqrtf(wave_sum(ss) * (1.0f / 512) + EPS);
      const float* g = p.q_norm + layer * 512 + lane * 8;
      v4u o; o.x = pk2(f[0] * r * g[0], f[1] * r * g[1]); o.y = pk2(f[2] * r * g[2], f[3] * r * g[3]); o.z = pk2(f[4] * r * g[4], f[5] * r * g[5]); o.w = pk2(f[6] * r * g[6], f[7] * r * g[7]);
      *(v4u*)((bf16*)(p.ws + WS_CQN) + (size_t)t * 512 + lane * 8) = o; }
    { const v2u w = *(const v2u*)(row + C_CKV + lane * 4);
      float f[4] = {bflo(w.x), bfhi(w.x), bflo(w.y), bfhi(w.y)};
      float ss = (f[0] * f[0] + f[1] * f[1]) + (f[2] * f[2] + f[3] * f[3]);
      const float r = 1.0f / sqrtf(wave_sum(ss) * (1.0f / 256) + EPS);
      const float* g = p.kv_norm + layer * 256 + lane * 4;
      v2u o; o.x = pk2(f[0] * r * g[0], f[1] * r * g[1]); o.y = pk2(f[2] * r * g[2], f[3] * r * g[3]);
      *(v2u*)((bf16*)(p.ws + WS_CKVN) + (size_t)t * 256 + lane * 4) = o; }
    if (lane < 16) {
        const float t1 = __builtin_bit_cast(float, (unsigned)row[C_KR + lane] << 16), t2 = __builtin_bit_cast(float, (unsigned)row[C_KR + 16 + lane] << 16);
        const float cs = ((const float*)(p.ws + WS_COS))[t * 16 + lane], sn = ((const float*)(p.ws + WS_SIN))[t * 16 + lane];
        bf16* kr = (bf16*)(p.ws + WS_KRR) + (size_t)t * 32;
        kr[lane] = (bf16)f2bf(t1 * cs - t2 * sn); kr[16 + lane] = (bf16)f2bf(t2 * cs + t1 * sn);
    } else if (lane < 22) {
        const int h = lane - 16;
        const float xv = __builtin_bit_cast(float, (unsigned)row[C_FB + h] << 16) + p.b_forget[layer * 6 + h];
        const float ls = fminf(xv, 0.f) - log1pf(expf(-fabsf(xv)));
        ((float*)(p.ws + WS_LOGF))[h * SEQ + t] = ls;
    }
}
__device__ __forceinline__ void prep1_qknorm(const bf16* row, int lane, float (&mq)[2], float (&mk)[2]) {
#pragma unroll
    for (int j = 0; j < 2; ++j) {
        float sq = 0.f, sk = 0.f;
        if (j == 0 || lane < 32) {
            const v4u a = *(const v4u*)(row + C_QB + j * 512 + lane * 8), b = *(const v4u*)(row + C_KB + j * 512 + lane * 8);
            float f[8]; f[0] = bflo(a.x); f[1] = bfhi(a.x); f[2] = bflo(a.y); f[3] = bfhi(a.y); f[4] = bflo(a.z); f[5] = bfhi(a.z); f[6] = bflo(a.w); f[7] = bfhi(a.w);
#pragma unroll
            for (int e = 0; e < 8; ++e) sq += f[e] * f[e];
            f[0] = bflo(b.x); f[1] = bfhi(b.x); f[2] = bflo(b.y); f[3] = bfhi(b.y); f[4] = bflo(b.z); f[5] = bfhi(b.z); f[6] = bflo(b.w); f[7] = bfhi(b.w);
#pragma unroll
            for (int e = 0; e < 8; ++e) sk += f[e] * f[e];
        }
#pragma unroll
        for (int o = 1; o < 16; o <<= 1) { sq += __shfl_xor(sq, o); sk += __shfl_xor(sk, o); }
        mq[j] = fmaxf(mq[j], sq); mk[j] = fmaxf(mk[j], sk);
    }
}
__device__ __forceinline__ void vt_item(const bf16* src, int src_stride, bf16* dst, int dst_stride, LAS unsigned short* scr, int lane) {
#pragma unroll
    for (int i = 0; i < 8; ++i) { const int r = i * 8 + (lane >> 3), ch = lane & 7; const v4u w = *(const v4u*)(src + (size_t)r * src_stride + ch * 8);
        LAS unsigned* d = (LAS unsigned*)(scr + r * 66 + ch * 8); d[0] = w.x; d[1] = w.y; d[2] = w.z; d[3] = w.w; }
    LDS_WAIT();
#pragma unroll
    for (int i = 0; i < 8; ++i) { const int c = i * 8 + (lane >> 3), ch = lane & 7; const LAS unsigned short* s = scr + (ch * 8) * 66 + c;
        v4u o; o.x = (unsigned)s[0] | ((unsigned)s[66] << 16); o.y = (unsigned)s[2 * 66] | ((unsigned)s[3 * 66] << 16); o.z = (unsigned)s[4 * 66] | ((unsigned)s[5 * 66] << 16); o.w = (unsigned)s[6 * 66] | ((unsigned)s[7 * 66] << 16);
        *(v4u*)(dst + (size_t)c * dst_stride + ch * 8) = o; }
    LDS_WAIT();
}

typedef short s16x4 __attribute__((ext_vector_type(4)));
#define KSWZ(row, colB) ((row) * 256 + ((colB) ^ (((row) & 7) << 4)))
#define SBAR() __builtin_amdgcn_sched_barrier(0)
constexpr int AT_SHM_V = 16384, AT_SHM_K = 16384;
constexpr int AT_V = 0, AT_K = 49152, AT_WS = 98304, AT_TAB = 100352, AT_WORD = 102912;
__device__ __forceinline__ int crow(int r, int hi) { return (r & 3) + 8 * (r >> 2) + 4 * hi; }
__device__ __forceinline__ unsigned cvtpk(float lo, float hi) { unsigned r; asm volatile("v_cvt_pk_bf16_f32 %0, %1, %2" : "=v"(r) : "v"(lo), "v"(hi)); return r; }

__device__ __forceinline__ void partialSM(f32x16& p0, f32x16& p1, float& m_reg, float& alpha, float C, float thr_u) {
    float pmax = p0[0];
#pragma unroll
    for (int r = 1; r < 16; ++r) pmax = fmaxf(pmax, p0[r]);
#pragma unroll
    for (int r = 0; r < 16; ++r) pmax = fmaxf(pmax, p1[r]);
    pmax = fmaxf(pmax, __shfl_xor(pmax, 32));
    float mn;
    if (__builtin_expect(__all(pmax - m_reg <= thr_u), 1)) { mn = m_reg; alpha = 1.f; }
    else { mn = fmaxf(m_reg, pmax); alpha = __builtin_amdgcn_exp2f((m_reg - mn) * C); m_reg = mn; }
    const float mnC = -mn * C;
#pragma unroll
    for (int r = 0; r < 16; ++r) p0[r] = __builtin_fmaf(p0[r], C, mnC);
#pragma unroll
    for (int r = 0; r < 16; ++r) p1[r] = __builtin_fmaf(p1[r], C, mnC);
#pragma unroll
    for (int r = 0; r < 16; ++r) p0[r] = __builtin_amdgcn_exp2f(p0[r]);
}
__device__ __forceinline__ void finishSM(f32x16& p0, f32x16& p1, float alpha, float& l_reg, bf16x8& pa0, bf16x8& pa1, bf16x8& pa2, bf16x8& pa3) {
#pragma unroll
    for (int r = 0; r < 16; ++r) p1[r] = __builtin_amdgcn_exp2f(p1[r]);
    float ps = 0;
#pragma unroll
    for (int r = 0; r < 16; ++r) ps += p0[r];
#pragma unroll
    for (int r = 0; r < 16; ++r) ps += p1[r];
    ps += __shfl_xor(ps, 32);
    l_reg = l_reg * alpha + ps;
#define PK4(P, BASE, OUT) do { unsigned a0 = cvtpk(P[BASE + 0], P[BASE + 1]), a1 = cvtpk(P[BASE + 2], P[BASE + 3]);   \
    unsigned b0 = cvtpk(P[BASE + 4], P[BASE + 5]), b1 = cvtpk(P[BASE + 6], P[BASE + 7]);                              \
    auto r0 = __builtin_amdgcn_permlane32_swap(a0, b0, false, false); auto r1 = __builtin_amdgcn_permlane32_swap(a1, b1, false, false); \
    v4u w_ = {r0[0], r1[0], r0[1], r1[1]}; OUT = __builtin_bit_cast(bf16x8, w_); } while (0)
    PK4(p0, 0, pa0); PK4(p0, 8, pa1); PK4(p1, 0, pa2); PK4(p1, 8, pa3);
#undef PK4
}
__device__ __forceinline__ int v_st(int k, int c) { const int kk = (k & ~0xC) | ((k & 4) << 1) | ((k & 8) >> 1); return ((kk >> 3) * 4 + (c >> 5)) * 512 + ((kk & 7) * 32 + (c & 31)) * 2; }
__device__ __forceinline__ int v_rd_base(int lane) { return ((lane & 3) << 3) | (((lane >> 2) & 3) << 6) | (((lane >> 4) & 1) << 5) | (((lane >> 5) & 1) << 8); }
constexpr int v_rd_off(int d0, int ks, int half) { return d0 * 512 + ks * 4096 + half * 2048; }
template <int OFF> __device__ __forceinline__ s16x4 tr_read(int vb) { s16x4 r; asm volatile("ds_read_b64_tr_b16 %0, %1 offset:%2" : "=&v"(r) : "v"(vb), "i"(OFF) : "memory"); return r; }
template <int D0> __device__ __forceinline__ void pv_one(f32x16& od, int vb, bf16x8 pa0, bf16x8 pa1, bf16x8 pa2, bf16x8 pa3) {
    const s16x4 l0 = tr_read<v_rd_off(D0, 0, 0)>(vb), h0 = tr_read<v_rd_off(D0, 0, 1)>(vb), l1 = tr_read<v_rd_off(D0, 1, 0)>(vb), h1 = tr_read<v_rd_off(D0, 1, 1)>(vb);
    const s16x4 l2 = tr_read<v_rd_off(D0, 2, 0)>(vb), h2 = tr_read<v_rd_off(D0, 2, 1)>(vb), l3 = tr_read<v_rd_off(D0, 3, 0)>(vb), h3 = tr_read<v_rd_off(D0, 3, 1)>(vb);
    asm volatile("s_waitcnt lgkmcnt(0)" ::: "memory"); SBAR();
#define PKV(L, H) (bf16x8){L[0], L[1], L[2], L[3], H[0], H[1], H[2], H[3]}
    od = __builtin_amdgcn_mfma_f32_32x32x16_bf16(pa0, PKV(l0, h0), od, 0, 0, 0);
    od = __builtin_amdgcn_mfma_f32_32x32x16_bf16(pa1, PKV(l1, h1), od, 0, 0, 0);
    od = __builtin_amdgcn_mfma_f32_32x32x16_bf16(pa2, PKV(l2, h2), od, 0, 0, 0);
    od = __builtin_amdgcn_mfma_f32_32x32x16_bf16(pa3, PKV(l3, h3), od, 0, 0, 0);
#undef PKV
}
__device__ __forceinline__ void pv_d0(f32x16 (&o)[4], int vb, bf16x8 pa0, bf16x8 pa1, bf16x8 pa2, bf16x8 pa3) {
    pv_one<0>(o[0], vb, pa0, pa1, pa2, pa3); pv_one<1>(o[1], vb, pa0, pa1, pa2, pa3); pv_one<2>(o[2], vb, pa0, pa1, pa2, pa3); pv_one<3>(o[3], vb, pa0, pa1, pa2, pa3);
}

template <int DK, int MODE>
__device__ __forceinline__ void attn_pass(LAS unsigned char* lds, const bf16* __restrict__ Qp, int qs, const bf16* __restrict__ Kp, int ks, const bf16* __restrict__ K2p,
                                          const bf16* __restrict__ Vp, int vs, int q0, int t_begin, int NT, float C,
                                          const float* __restrict__ cumF, const int* __restrict__ pos, const float* __restrict__ cosT, const float* __restrict__ sinT,
                                          const int* __restrict__ pmax64, f32x16 (&o)[4]) {
    const int tid = tid_opaque(), wid = __builtin_amdgcn_readfirstlane(tid >> 6), lane = tid & 63, r32 = lane & 31, hi = lane >> 5;
    const int qrow = q0 + wid * 32 + r32;
#ifdef DBG_THR0
    const float thr_u = 0.0f;
#else
    const float thr_u = 8.0f * LOG2E / C;
#endif
    LAS const float* tab = (LAS const float*)(lds + AT_TAB);
    LAS float* wsl = (LAS float*)(lds + AT_WS) + wid * 64; LAS float* li_l = wsl; LAS float* al_l = wsl + 32;
    float m_reg = -1e30f, l_reg = 0.f;
#pragma unroll
    for (int d = 0; d < 4; ++d)
#pragma unroll
        for (int i = 0; i < 16; ++i) o[d][i] = 0.f;
    bf16x8 qr[DK / 16];
#pragma unroll
    for (int kk = 0; kk < DK / 16; ++kk) qr[kk] = *(const bf16x8*)(Qp + (size_t)qrow * qs + kk * 16 + hi * 8);
    if constexpr (MODE == 2) {
        const float* cp = cosT + (size_t)qrow * 16 + hi * 8; const float* sp = sinT + (size_t)qrow * 16 + hi * 8;
        bf16x8 a = qr[4], b = qr[5];
#pragma unroll
        for (int j = 0; j < 8; ++j) { const float t1 = __builtin_bit_cast(float, (unsigned)(unsigned short)a[j] << 16), t2 = __builtin_bit_cast(float, (unsigned)(unsigned short)b[j] << 16);
            const float cs = cp[j], sn = sp[j]; a[j] = (short)f2bf(t1 * cs - t2 * sn); b[j] = (short)f2bf(t2 * cs + t1 * sn); }
        qr[4] = a; qr[5] = b;
    }
    int posq = 0, qpmin = 0; float FrefS = 0.f;
    if constexpr (MODE == 0) { posq = pos[qrow]; int mn = posq;
#pragma unroll
        for (int s = 1; s < 64; s <<= 1) mn = min(mn, __shfl_xor(mn, s));
        qpmin = mn; }
    if constexpr (MODE == 1) FrefS = cumF[q0] * 11.313708498984761f;
    const int cq = (MODE == 3) ? NT : ((q0 + wid * 32) >> 6);
    const int sr = tid >> 4, cidx = tid & 15, sc = cidx * 8, vst0 = v_st(sr, sc), vst1 = v_st(32 + sr, sc);
    const bool kact = cidx < DK / 8;
    const int vb0 = (int)(unsigned)(uintptr_t)(lds + AT_V) + v_rd_base(lane);
    bf16x8 sv0[1], sv1[1], sk0[1], sk1[1];
#define KPTR(row) ((MODE == 2 && cidx >= 8) ? K2p + (size_t)(row) * 32 + (cidx - 8) * 8 : Kp + (size_t)(row) * ks + sc)
#define SLOAD(i, t) do { const int k0_ = (t) * 64; sv0[i] = *(const bf16x8*)(Vp + (size_t)(k0_ + sr) * vs + sc); sv1[i] = *(const bf16x8*)(Vp + (size_t)(k0_ + 32 + sr) * vs + sc); \
        if (kact) { sk0[i] = *(const bf16x8*)KPTR(k0_ + sr); sk1[i] = *(const bf16x8*)KPTR(k0_ + 32 + sr); } } while (0)
#define SWRITE(b, i) do { *(LAS bf16x8*)(lds + AT_V + (b) * AT_SHM_V + vst0) = sv0[i]; *(LAS bf16x8*)(lds + AT_V + (b) * AT_SHM_V + vst1) = sv1[i]; \
        if (kact) { *(LAS bf16x8*)(lds + AT_K + (b) * AT_SHM_K + KSWZ(sr, sc * 2)) = sk0[i]; *(LAS bf16x8*)(lds + AT_K + (b) * AT_SHM_K + KSWZ(32 + sr, sc * 2)) = sk1[i]; } } while (0)
#define SWAIT4() asm volatile("s_waitcnt vmcnt(4)" ::: "memory")
#define RESC(a) do { if (__any((a) < 1.f)) { if (hi == 0) al_l[r32] = (a); asm volatile("s_waitcnt lgkmcnt(0)" ::: "memory"); \
        _Pragma("unroll") for (int d = 0; d < 4; ++d) _Pragma("unroll") for (int r = 0; r < 16; ++r) o[d][r] *= al_l[crow(r, hi)]; } } while (0)
    auto qkt = [&](f32x16& p0, f32x16& p1, int kb, int t) {
        if constexpr (MODE == 0) { const float ci = (pmax64[t] - qpmin > -RELC) ? 0.f : tab[0];
#pragma unroll
            for (int i = 0; i < 16; ++i) { p0[i] = ci; p1[i] = ci; } }
        else if constexpr (MODE == 1) { const float* fp = cumF + t * 64 + 4 * hi;
#pragma unroll
            for (int g = 0; g < 4; ++g) { const f32x4 a = *(const f32x4*)(fp + 8 * g), b = *(const f32x4*)(fp + 32 + 8 * g);
#pragma unroll
                for (int e = 0; e < 4; ++e) { p0[4 * g + e] = __builtin_fmaf(a[e], -11.313708498984761f, FrefS); p1[4 * g + e] = __builtin_fmaf(b[e], -11.313708498984761f, FrefS); } } }
        else {
#pragma unroll
            for (int i = 0; i < 16; ++i) { p0[i] = 0.f; p1[i] = 0.f; } }
        LAS const unsigned char* Ks = lds + AT_K + kb * AT_SHM_K;
#pragma unroll
        for (int d0 = 0; d0 < DK / 16; ++d0) { const int cb = (d0 * 16 + hi * 8) * 2;
            const bf16x8 b0 = *(LAS const bf16x8*)(Ks + KSWZ(r32, cb));
            const bf16x8 b1 = *(LAS const bf16x8*)(Ks + KSWZ(32 + r32, cb));
            p0 = __builtin_amdgcn_mfma_f32_32x32x16_bf16(b0, qr[d0], p0, 0, 0, 0);
            p1 = __builtin_amdgcn_mfma_f32_32x32x16_bf16(b1, qr[d0], p1, 0, 0, 0); }
    };
    auto post = [&](f32x16& p0, f32x16& p1, int t) {
        if constexpr (MODE == 0) {
            if (pmax64[t] - qpmin > -RELC) {
                const int* pp = pos + t * 64 + 4 * hi;
#pragma unroll
                for (int g = 0; g < 4; ++g) { const v4i a = *(const v4i*)(pp + 8 * g), b = *(const v4i*)(pp + 32 + 8 * g);
#pragma unroll
                    for (int e = 0; e < 4; ++e) { const int ra = min(max(a[e] - posq, -RELC), RELC) + RELC, rb = min(max(b[e] - posq, -RELC), RELC) + RELC;
                        p0[4 * g + e] += tab[ra]; p1[4 * g + e] += tab[rb]; } }
            }
        }
        if constexpr (MODE == 1) {
            if (t == cq) { const int kb0 = t * 64 + 4 * hi;
#pragma unroll
                for (int i = 0; i < 16; ++i) { const int kv = kb0 + (i & 3) + 8 * (i >> 2); if (kv > qrow) p0[i] = -1e30f; if (kv + 32 > qrow) p1[i] = -1e30f; } }
        }
    };
    int tdense_end = (MODE == 3) ? NT : (q0 >> 6);
    int nd = tdense_end - t_begin; nd &= ~1; if (nd < 2) nd = 0;
#ifdef DBG_NODENSE
    nd = 0;
#endif
    const int tb = t_begin;
    if (nd) {
        f32x16 pA0, pA1, pB0, pB1; float alA, alB; bf16x8 pa0, pa1, pa2, pa3;
        SLOAD(0, tb); asm volatile("s_waitcnt vmcnt(0)" ::: "memory"); SWRITE(0, 0); __syncthreads();
        qkt(pA0, pA1, 0, tb); post(pA0, pA1, tb); partialSM(pA0, pA1, m_reg, alA, C, thr_u);
        SLOAD(0, tb + 1);
        SWRITE(1, 0); __syncthreads();
        int bp = 0, bc = 1, bn = 2;
        for (int j = 1; j + 1 < nd; j += 2) {
            SBAR(); qkt(pB0, pB1, bc, tb + j);
            finishSM(pA0, pA1, alA, l_reg, pa0, pa1, pa2, pa3); SBAR();
            SLOAD(0, tb + j + 1); SBAR();
            pv_d0(o, vb0 + bp * AT_SHM_V, pa0, pa1, pa2, pa3); post(pB0, pB1, tb + j); partialSM(pB0, pB1, m_reg, alB, C, thr_u);
            SWRITE(bn, 0);
            RESC(alB); __syncthreads();
            { const int t_ = bp; bp = bc; bc = bn; bn = t_; }
            SBAR(); qkt(pA0, pA1, bc, tb + j + 1);
            finishSM(pB0, pB1, alB, l_reg, pa0, pa1, pa2, pa3); SBAR();
            SLOAD(0, tb + j + 2); SBAR();
            pv_d0(o, vb0 + bp * AT_SHM_V, pa0, pa1, pa2, pa3); post(pA0, pA1, tb + j + 1); partialSM(pA0, pA1, m_reg, alA, C, thr_u);
            SWRITE(bn, 0);
            RESC(alA); __syncthreads();
            { const int t_ = bp; bp = bc; bc = bn; bn = t_; }
        }
        SBAR(); qkt(pB0, pB1, bc, tb + nd - 1);
        finishSM(pA0, pA1, alA, l_reg, pa0, pa1, pa2, pa3); SBAR();
        pv_d0(o, vb0 + bp * AT_SHM_V, pa0, pa1, pa2, pa3); post(pB0, pB1, tb + nd - 1); partialSM(pB0, pB1, m_reg, alB, C, thr_u);
        RESC(alB);
        finishSM(pB0, pB1, alB, l_reg, pa0, pa1, pa2, pa3); SBAR();
        pv_d0(o, vb0 + bc * AT_SHM_V, pa0, pa1, pa2, pa3);
        __syncthreads();
    }
    for (int t = tb + nd; t < NT; ++t) {
        SLOAD(0, t); asm volatile("s_waitcnt vmcnt(0)" ::: "memory"); SWRITE(0, 0); __syncthreads();
        if (t <= cq) {
            f32x16 p0, p1; float al; bf16x8 pa0, pa1, pa2, pa3;
            qkt(p0, p1, 0, t); post(p0, p1, t); partialSM(p0, p1, m_reg, al, C, thr_u);
            finishSM(p0, p1, al, l_reg, pa0, pa1, pa2, pa3);
            RESC(al);
            pv_d0(o, vb0, pa0, pa1, pa2, pa3);
        }
        __syncthreads();
    }
    if (hi == 0) li_l[r32] = l_reg;
    asm volatile("s_waitcnt lgkmcnt(0)" ::: "memory");
#pragma unroll
    for (int r = 0; r < 16; ++r) {
#ifdef DBG_DIRECT
        const float rl = 1.0f / __shfl(l_reg, crow(r, hi));
#else
        const float rl = __builtin_amdgcn_rcpf(li_l[crow(r, hi)]);
#endif
#pragma unroll
        for (int d = 0; d < 4; ++d) o[d][r] *= rl; }
#undef KPTR
#undef SLOAD
#undef SWRITE
#undef SWAIT4
#undef RESC
}

__device__ __forceinline__ void attn_finish(LAS unsigned char* lds, f32x16 (&o)[4], bool do_rms, float rr_scale, const float* gain, bf16* obuf, int ostride, int q0, int col0) {
    const int tid = tid_opaque(), wid = __builtin_amdgcn_readfirstlane(tid >> 6), lane = tid & 63, r32 = lane & 31, hi = lane >> 5;
    float g4[4] = {1.f, 1.f, 1.f, 1.f};
    if (gain) {
#pragma unroll
        for (int d = 0; d < 4; ++d) g4[d] = gain[col0 + d * 32 + r32];
    }
#ifdef DBG_DIRECT
#pragma unroll
    for (int r = 0; r < 16; ++r) {
        float rr = rr_scale;
        if (do_rms) {
            float ss = (o[0][r] * o[0][r] + o[1][r] * o[1][r]) + (o[2][r] * o[2][r] + o[3][r] * o[3][r]);
#pragma unroll
            for (int s = 1; s < 32; s <<= 1) ss += __shfl_xor(ss, s);
            rr = rr_scale / sqrtf(ss * (1.0f / 128) + EPS);
        }
        const int row = crow(r, hi);
#pragma unroll
        for (int d = 0; d < 4; ++d) obuf[(size_t)(q0 + wid * 32 + row) * ostride + col0 + d * 32 + r32] = (unsigned short)f2bf(o[d][r] * rr * g4[d]);
    }
}
#else
    LAS unsigned short* stg = (LAS unsigned short*)(lds + wid * 8192);
#pragma unroll
    for (int r = 0; r < 16; ++r) {
        float rr = rr_scale;
        if (do_rms) {
            float ss = (o[0][r] * o[0][r] + o[1][r] * o[1][r]) + (o[2][r] * o[2][r] + o[3][r] * o[3][r]);
#pragma unroll
            for (int s = 1; s < 32; s <<= 1) ss += __shfl_xor(ss, s);
            rr = rr_scale / sqrtf(ss * (1.0f / 128) + EPS);
        }
        const int row = crow(r, hi);
#pragma unroll
        for (int d = 0; d < 4; ++d) stg[row * 128 + d * 32 + r32] = (unsigned short)f2bf(o[d][r] * rr * g4[d]);
    }
    LDS_WAIT();
#pragma unroll
    for (int i = 0; i < 8; ++i) { const int c = i * 64 + lane, row = c >> 4, ch = c & 15;
        const v4u v = *(LAS const v4u*)(stg + row * 128 + ch * 8);
        *(v4u*)(obuf + (size_t)(q0 + wid * 32 + row) * ostride + col0 + ch * 8) = v; }
    LDS_WAIT();
}
#endif

__device__ __forceinline__ void self_attn_A(const Params& p, LAS unsigned char* lds, int layer, int h, int qb) {
    const int tid = tid_opaque(), lane = tid & 63, wid = __builtin_amdgcn_readfirstlane(tid >> 6);
    const int q0 = qb * 256, NT = q0 / 64 + 4;
    const bf16* proj = (const bf16*)(p.ws + WS_PROJ);
    { LAS float* tab = (LAS float*)(lds + AT_TAB); const float* tg = (const float*)(p.ws + WS_TAB) + h * NTAB; for (int i = tid; i < NTAB; i += 512) tab[i] = tg[i]; }
    __syncthreads();
    unsigned* park = (unsigned*)(p.ws + WS_VTA) + ((size_t)(blockIdx.x * 8 + wid) * 64 + lane) * 32;
    for (int mp = 0; mp < 2; ++mp) {
        f32x16 o[4];
        attn_pass<64, 0>(lds, proj + C_QA + h * 128 + mp * 64, NP1, proj + C_KA + h * 128 + mp * 64, NP1, nullptr, proj + C_VA + h * 128, NP1, q0, 0, NT, 0.125f * LOG2E,
                         nullptr, p.pos, nullptr, nullptr, (const int*)(p.ws + WS_TAB + 16384), o);
        if (mp == 0) {
#pragma unroll
            for (int d = 0; d < 4; ++d)
#pragma unroll
                for (int r = 0; r < 8; ++r) park[d * 8 + r] = pk2(o[d][2 * r], o[d][2 * r + 1]);
        } else {
            const float* lm = p.lam + layer * 256;
            const float d01 = wave_sum(lm[lane] * lm[64 + lane]), d23 = wave_sum(lm[128 + lane] * lm[192 + lane]);
            const float li = p.lam_init[layer], lamv = expf(d01) - expf(d23) + li;
            LDS_WAIT();
#pragma unroll
            for (int d = 0; d < 4; ++d)
#pragma unroll
                for (int r = 0; r < 8; ++r) { const unsigned w = __hip_atomic_load(park + d * 8 + r, __ATOMIC_RELAXED, __HIP_MEMORY_SCOPE_AGENT); o[d][2 * r] = bflo(w) - lamv * o[d][2 * r]; o[d][2 * r + 1] = bfhi(w) - lamv * o[d][2 * r + 1]; }
            attn_finish(lds, o, true, 1.0f - li, p.head_norm + layer * 2048, (bf16*)(p.ws + WS_O), DM, q0, h * 128);
        }
    }
}
__device__ __forceinline__ void self_attn_B(const Params& p, LAS unsigned char* lds, int layer, int h, int qb) {
    const int tid = tid_opaque();
    const int q0 = qb * 256, NT = q0 / 64 + 4;
    const bf16* proj = (const bf16*)(p.ws + WS_PROJ);
    const float* cumF = (const float*)(p.ws + WS_CUMF) + (size_t)h * SEQ;
    int t_begin = 0;
    {
        LAS int* tbp = (LAS int*)(lds + AT_WORD + 64);
        if (tid == 0) *tbp = q0 / 64;
        __syncthreads();
        const unsigned* nb = (const unsigned*)(p.ws + WS_CTL) + 64 + layer * 16 + h * 2;
        const float B = 0.08838834764831845f * sqrtf(__builtin_bit_cast(float, nb[0]) * __builtin_bit_cast(float, nb[1]));
        const float Fq = cumF[q0];
        if (tid < q0 / 64) { const float bound = 2.0f * B + (Fq - cumF[tid * 64 + 63]) + 9.0f; if (bound >= -105.0f) __hip_atomic_fetch_min(tbp, tid, __ATOMIC_RELAXED, __HIP_MEMORY_SCOPE_WORKGROUP); }
        __syncthreads();
        t_begin = __builtin_amdgcn_readfirstlane(*tbp);
    }
    f32x16 o[4];
    attn_pass<128, 1>(lds, proj + C_QB + h * 128, NP1, proj + C_KB + h * 128, NP1, nullptr, proj + C_VB + h * 128, NP1, q0, t_begin, NT, 0.08838834764831845f * LOG2E,
                      cumF, nullptr, nullptr, nullptr, nullptr, o);
    attn_finish(lds, o, true, 1.0f, p.head_norm + layer * 2048, (bf16*)(p.ws + WS_O), DM, q0, 512 + h * 128);
}
__device__ __forceinline__ void self_attn_C(const Params& p, LAS unsigned char* lds, int layer, int h, int qb) {
    const int q0 = qb * 256, NT = q0 / 64 + 4;
    f32x16 o[4];
    attn_pass<96, 2>(lds, (const bf16*)(p.ws + WS_QC) + h * 96, NQC, (const bf16*)(p.ws + WS_KVC) + h * 192, NKVC, (const bf16*)(p.ws + WS_KRR), (const bf16*)(p.ws + WS_KVC) + h * 192 + 64, NKVC,
                     q0, 0, NT, 0.10206207261596575f * LOG2E, nullptr, nullptr, (const float*)(p.ws + WS_COS), (const float*)(p.ws + WS_SIN), nullptr, o);
    attn_finish(lds, o, true, 1.0f, p.head_norm + layer * 2048, (bf16*)(p.ws + WS_O), DM, q0, 1280 + h * 128);
}

__device__ __forceinline__ float gelu_tanh(float x) {
    const float z = 0.7978845608028654f * (x + 0.044715f * x * x * x);
    const float e = __builtin_amdgcn_exp2f(z * (2.0f * LOG2E));
    const float th = 1.0f - 2.0f * __builtin_amdgcn_rcpf(e + 1.0f);
    return 0.5f * x * (1.0f + th);
}
__device__ __forceinline__ void unpack8(const v4u w, float (&f)[8]) { f[0] = bflo(w.x); f[1] = bfhi(w.x); f[2] = bflo(w.y); f[3] = bfhi(w.y); f[4] = bflo(w.z); f[5] = bfhi(w.z); f[6] = bflo(w.w); f[7] = bfhi(w.w); }
__device__ __forceinline__ void convgate_task(const Params& p, int layer, int rs, int cgp) {
    const bf16* U = (const bf16*)(p.ws + WS_U); bf16* A = (bf16*)(p.ws + WS_A);
    const int j0 = cgp * 8, t0 = rs * 32;
    const float* cw = p.conv_w + (size_t)layer * 3 * 8192; const float* cb = p.conv_b + (size_t)layer * 8192;
    float wg[3][8], wv[3][8], bg[8], bv[8];
#pragma unroll
    for (int tp = 0; tp < 3; ++tp)
#pragma unroll
        for (int j = 0; j < 8; ++j) { wg[tp][j] = cw[tp * 8192 + j0 + j]; wv[tp][j] = cw[tp * 8192 + 4096 + j0 + j]; }
#pragma unroll
    for (int j = 0; j < 8; ++j) { bg[j] = cb[j0 + j]; bv[j] = cb[4096 + j0 + j]; }
    float g2[8], g1[8], v2[8], v1[8];
#pragma unroll
    for (int j = 0; j < 8; ++j) { g2[j] = g1[j] = v2[j] = v1[j] = 0.f; }
    if (t0 >= 2) {
        unpack8(*(const v4u*)(U + (size_t)(t0 - 2) * 8192 + j0), g2); unpack8(*(const v4u*)(U + (size_t)(t0 - 2) * 8192 + 4096 + j0), v2);
        unpack8(*(const v4u*)(U + (size_t)(t0 - 1) * 8192 + j0), g1); unpack8(*(const v4u*)(U + (size_t)(t0 - 1) * 8192 + 4096 + j0), v1);
    }
#pragma unroll 4
    for (int t = t0; t < t0 + 32; ++t) {
        float g0[8], v0[8];
        unpack8(__builtin_nontemporal_load((const v4u*)(U + (size_t)t * 8192 + j0)), g0); unpack8(__builtin_nontemporal_load((const v4u*)(U + (size_t)t * 8192 + 4096 + j0)), v0);
        float r[8];
#pragma unroll
        for (int j = 0; j < 8; ++j) {
            const float cgv = bg[j] + g2[j] * wg[0][j] + g1[j] * wg[1][j] + g0[j] * wg[2][j];
            const float cvv = bv[j] + v2[j] * wv[0][j] + v1[j] * wv[1][j] + v0[j] * wv[2][j];
            r[j] = gelu_tanh(cgv) * cvv;
            g2[j] = g1[j]; g1[j] = g0[j]; v2[j] = v1[j]; v1[j] = v0[j];
        }
        v4u o; o.x = pk2(r[0], r[1]); o.y = pk2(r[2], r[3]); o.z = pk2(r[4], r[5]); o.w = pk2(r[6], r[7]);
        *(v4u*)(A + (size_t)t * 4096 + j0) = o;
    }
}

constexpr int CW_BAR = 4096, MISC_OFF = 139264;
#define XB_TMO      128
#define XB_XCNT(j)  (256  + 64 * (j))
#define XB_XSUB(j)  (1280 + 64 * (j))
#define XB_XGEN(j)  (2304 + 64 * (j))
#define XB_TOP      3328
#define XB_TOPGEN   3392
#define XCD_BAR_WORDS 3456
#define XB_SPIN_CAP (1u << 18)

__device__ __forceinline__ unsigned xb_ld(unsigned* p)              { return __hip_atomic_load(p, __ATOMIC_RELAXED, __HIP_MEMORY_SCOPE_AGENT); }
__device__ __forceinline__ unsigned xb_add(unsigned* p, unsigned v) { return __hip_atomic_fetch_add(p, v, __ATOMIC_RELAXED, __HIP_MEMORY_SCOPE_AGENT); }
__device__ __forceinline__ unsigned xb_xcc_id() { return (unsigned)__builtin_amdgcn_s_getreg((3 << 11) | 20) & 0xFu; }
#define XB_SPIN(cond, bar) do { unsigned _sp = 0; while (cond) { __builtin_amdgcn_s_sleep(1); \
    if ((++_sp & 255u) == 0u) { if (xb_ld(&(bar)[XB_TMO])) break; if (_sp > XB_SPIN_CAP) { atomicAdd(&(bar)[XB_TMO], 1u); break; } } } } while (0)

struct XcdBarrier {
    unsigned* bar; unsigned x;
    volatile LAS unsigned* st;
};

__device__ __forceinline__ XcdBarrier xcd_barrier_post(unsigned* bar, volatile LAS unsigned* st) {
    XcdBarrier b; b.bar = bar; b.x = xb_xcc_id(); b.st = st;
    if (threadIdx.x == 0) (void)xb_add(&bar[XB_XCNT(b.x)], 1u);
    return b;
}
__device__ __forceinline__ void xcd_barrier_complete(unsigned* bar, unsigned x, unsigned& nloc, unsigned& nx) {
    const unsigned G = gridDim.x * gridDim.y * gridDim.z;
    unsigned sum, cnt, mine, sp = 0u;
    for (;;) {
        sum = 0u; cnt = 0u; mine = 0u;
#pragma unroll
        for (unsigned j = 0; j < 16; ++j) { const unsigned c = xb_ld(&bar[XB_XCNT(j)]); sum += c; cnt += (c > 0u) ? 1u : 0u; mine = (j == x) ? c : mine; }
        if (sum == G) break;
        __builtin_amdgcn_s_sleep(1);
        if ((++sp & 255u) == 0u) { if (xb_ld(&bar[XB_TMO])) break; if (sp > XB_SPIN_CAP) { atomicAdd(&bar[XB_TMO], 1u); break; } }
    }
    nloc = mine > 0u ? mine : 1u; nx = cnt > 0u ? cnt : 1u;
}

__device__ __forceinline__ void xcd_barrier(const XcdBarrier& b) {
    asm volatile("s_waitcnt vmcnt(0)" ::: "memory");
    __syncthreads();
    if (threadIdx.x == 0) {
        unsigned* bar = b.bar;
        __builtin_amdgcn_s_waitcnt(0);
        unsigned nloc = b.st[0], nx = b.st[1];
        if (nloc == 0u) { xcd_barrier_complete(bar, b.x, nloc, nx); b.st[0] = nloc; b.st[1] = nx; }
        const unsigned old = xb_add(&bar[XB_XSUB(b.x)], 1u);
        const unsigned gen = old / nloc;
        if (old + 1u == (gen + 1u) * nloc) {
            __builtin_amdgcn_fence(__ATOMIC_RELEASE, "agent");
            asm volatile("s_waitcnt vmcnt(0)" ::: "memory");
            const unsigned og = xb_add(&bar[XB_TOP], 1u);
            const unsigned tg = og / nx;
            if (og + 1u == (tg + 1u) * nx) xb_add(&bar[XB_TOPGEN], 1u);
            else XB_SPIN(xb_ld(&bar[XB_TOPGEN]) == tg, bar);
            __builtin_amdgcn_fence(__ATOMIC_ACQUIRE, "agent");
            xb_add(&bar[XB_XGEN(b.x)], 1u);
            asm volatile("s_waitcnt vmcnt(0)" ::: "memory");
        } else {
            XB_SPIN(xb_ld(&bar[XB_XGEN(b.x)]) == gen, bar);
            __builtin_amdgcn_fence(__ATOMIC_ACQUIRE, "agent");
            asm volatile("s_waitcnt vmcnt(0)" ::: "memory");
        }
    }
    __syncthreads();
}

struct GemmJob { const bf16* A; const bf16* Bt; void* C; int M, N, K, ldc, f32, cshift; };
__device__ __forceinline__ GemmJob gemm_job(unsigned char* ws, int id) {
    GemmJob J;
    switch (id) {
    case 0:  J = GemmJob{(const bf16*)(ws + WS_H),    (const bf16*)(ws + WS_WT + WT_IN),   ws + WS_PROJ, SEQ,  NP1,  DM,  NP1,  0, 0};  break;
    case 1:  J = GemmJob{(const bf16*)(ws + WS_MEMN), (const bf16*)(ws + WS_WT + WT_KVX),  ws + WS_KVX,  NMEM, 1024, DM,  1024, 0, 64}; break;
    case 2:  J = GemmJob{(const bf16*)(ws + WS_CQN),  (const bf16*)(ws + WS_WT + WT_UQ),   ws + WS_QC,   SEQ,  NQC,  512, NQC,  0, 0};  break;
    case 3:  J = GemmJob{(const bf16*)(ws + WS_CKVN), (const bf16*)(ws + WS_WT + WT_UKV),  ws + WS_KVC,  SEQ,  NKVC, 256, NKVC, 0, 64}; break;
    case 4:  J = GemmJob{(const bf16*)(ws + WS_O),    (const bf16*)(ws + WS_WT + WT_OUT),  ws + WS_Y,    SEQ,  DM,   DM,  DM,   0, 0};  break;
    case 5:  J = GemmJob{(const bf16*)(ws + WS_H),    (const bf16*)(ws + WS_WT + WT_QX),   ws + WS_QX,   SEQ,  512,  DM,  512,  0, 0};  break;
    case 6:  J = GemmJob{(const bf16*)(ws + WS_OX),   (const bf16*)(ws + WS_WT + WT_OX),   ws + WS_Y,    SEQ,  DM,   512, DM,   0, 0};  break;
    case 7:  J = GemmJob{(const bf16*)(ws + WS_H),    (const bf16*)(ws + WS_WT + WT_UP),   ws + WS_U,    SEQ,  8192, DM,  8192, 0, 0};  break;
    default: J = GemmJob{(const bf16*)(ws + WS_A),    (const bf16*)(ws + WS_WT + WT_DOWN), ws + WS_Y,    SEQ,  DM,   DFF, DM,   0, 0};  break;
    }
    return J;
}

__global__ void __launch_bounds__(512, 2) mega_fwd(Params p_unused) {
    extern __shared__ __attribute__((aligned(16))) unsigned char lds_raw[];
    LAS unsigned char* lds = (LAS unsigned char*)lds_raw;
    cg::grid_group grid = cg::this_grid();
    const Params* pp0 = (const Params*)__builtin_amdgcn_kernarg_segment_ptr();
    const int G = gridDim.x, bx = blockIdx.x, NGW = G * 8;
    {
    const Params* pp = pp0; asm volatile("" : "+s"(pp));
    const Params& p = *pp;
    const int tid = tid_opaque();
    unsigned char* ws = p.ws;
    unsigned* ctl = (unsigned*)(ws + WS_CTL);
    {
        if (bx == 0) for (int i = tid; i < CW_BAR + XCD_BAR_WORDS; i += 512) ctl[i] = 0u;
        if (tid < 2) ((LAS unsigned*)(lds + MISC_OFF))[tid] = 0u;
        const int gt = bx * 512 + tid, NT_ = G * 512;
        for (int i = gt; i < SEQ * 16; i += NT_) {
            const int t = i >> 4, k = i & 15;
            const float inv = (float)exp(-(double)(2 * k) / 32.0 * 9.210340371976184);
            const float ang = (float)p.pos[t] * inv;
            const double xd = (double)ang, kq = rint(xd * 0.6366197723675814), r = (xd - kq * 1.5707963267948966) - kq * 6.123233995736766e-17, r2 = r * r;
            const double sn = r * (1.0 + r2 * (-1.0 / 6 + r2 * (1.0 / 120 + r2 * (-1.0 / 5040 + r2 * (1.0 / 362880 - r2 / 39916800)))));
            const double cs = 1.0 + r2 * (-0.5 + r2 * (1.0 / 24 + r2 * (-1.0 / 720 + r2 * (1.0 / 40320 + r2 * (-1.0 / 3628800 + r2 / 479001600)))));
            const int q = (int)((long long)kq & 3);
            const double s_ = (q == 0) ? sn : (q == 1) ? cs : (q == 2) ? -sn : -cs, c_ = (q == 0) ? cs : (q == 1) ? -sn : (q == 2) ? -cs : sn;
            ((float*)(ws + WS_COS))[i] = (float)c_; ((float*)(ws + WS_SIN))[i] = (float)s_;
        }
        for (int i = gt; i < 4 * NTAB; i += NT_) {
            const int h = i / NTAB, rel = i % NTAB - RELC, n = rel < 0 ? -rel : rel;
            const float nf = (float)(n > 1 ? n : 1);
            int large = 8 + (int)(logf(nf / 8.0f) / 4.1588830833596715f * 8.0f); large = large < 15 ? large : 15;
            const int bucket = (rel > 0 ? 16 : 0) + (n < 8 ? n : large);
            ((float*)(ws + WS_TAB))[i] = p.rel_bias[bucket * 4 + h] * 8.0f;
        }
        for (int i = gt; i < SEQ / 64; i += NT_) { int mx = p.pos[i * 64]; for (int j = 1; j < 64; ++j) mx = max(mx, p.pos[i * 64 + j]); ((int*)(ws + WS_TAB + 16384))[i] = mx; }
    }
    }

    constexpr int NSTEP = 14;
    for (int step = 0; step <= DEPTH * NSTEP; ++step) {
        const Params* pp = pp0; asm volatile("" : "+s"(pp));
        const Params& p = *pp;
        const int tid = tid_opaque();
        const int lane = tid & 63, wave = __builtin_amdgcn_readfirstlane(tid >> 6), gw = bx * 8 + wave;
        unsigned char* ws = p.ws;
        unsigned* ctl = (unsigned*)(ws + WS_CTL);
        const int layer = step / NSTEP, k = step - layer * NSTEP;
        int job0 = 0, njob = 0;
        switch (k) {
        case 0: {
#ifndef NO_WN
            if (layer < DEPTH) {
                LAS float* scr = (LAS float*)(lds + wave * 16384);
                int base = 0;
                wt_matrix(p.w_in + (size_t)layer * DM * D_IN, DM, D_IN, NP1, (bf16*)(ws + WS_WT + WT_IN), scr, base, gw, NGW, lane, MapIn{});
                wt_matrix(p.w_uq + (size_t)layer * 512 * 576, 512, 576, NQC, (bf16*)(ws + WS_WT + WT_UQ), scr, base, gw, NGW, lane, MapPad{576});
                wt_matrix(p.w_ukv + (size_t)layer * 256 * 1152, 256, 1152, NKVC, (bf16*)(ws + WS_WT + WT_UKV), scr, base, gw, NGW, lane, MapPad{1152});
                wt_matrix(p.w_out + (size_t)layer * DM * DM, DM, DM, DM, (bf16*)(ws + WS_WT + WT_OUT), scr, base, gw, NGW, lane, MapPad{DM});
                wt_matrix(p.wq_x + (size_t)layer * DM * 512, DM, 512, 512, (bf16*)(ws + WS_WT + WT_QX), scr, base, gw, NGW, lane, MapPad{512});
                wt_matrix(p.wkv_x + (size_t)layer * DM * 1024, DM, 1024, 1024, (bf16*)(ws + WS_WT + WT_KVX), scr, base, gw, NGW, lane, MapPad{1024});
                wt_matrix(p.wo_x + (size_t)layer * 512 * DM, 512, DM, DM, (bf16*)(ws + WS_WT + WT_OX), scr, base, gw, NGW, lane, MapPad{DM});
                wt_matrix(p.w_up + (size_t)layer * DM * 8192, DM, 8192, 8192, (bf16*)(ws + WS_WT + WT_UP), scr, base, gw, NGW, lane, MapPad{8192});
                wt_matrix(p.w_down + (size_t)layer * DFF * DM, DFF, DM, DM, (bf16*)(ws + WS_WT + WT_DOWN), scr, base, gw, NGW, lane, MapPad{DM});
                for (int r = gw; r < NMEM; r += NGW) norm_row(p.mem + (size_t)r * DM, nullptr, nullptr, p.mem_norm + (size_t)layer * DM, nullptr, (bf16*)(ws + WS_MEMN) + (size_t)r * DM, lane);
            }
#endif
        }
        case 6: case 10: {
            const float* xin = (step == 0) ? p.x : p.out;
            const bf16* y = (step == 0) ? nullptr : (const bf16*)(ws + WS_Y);
            const float* gpost = (k == 0) ? p.norm_gains + (size_t)((layer > 0 ? layer - 1 : 0) * 6 + 5) * DM : p.norm_gains + (size_t)(layer * 6 + (k == 6 ? 1 : 3)) * DM;
            const float* gpre = (layer < DEPTH) ? p.norm_gains + (size_t)(layer * 6 + (k == 0 ? 0 : (k == 6 ? 2 : 4))) * DM : nullptr;
            for (int r = gw; r < SEQ; r += NGW)
                norm_row(xin + (size_t)r * DM, y ? y + (size_t)r * DM : nullptr, gpost, gpre, p.out + (size_t)r * DM, gpre ? (bf16*)(ws + WS_H) + (size_t)r * DM : nullptr, lane);
        } break;
        case 1: job0 = 0; njob = 2; break;
        case 2: {
#ifndef NO_PREP1
            { float mq[2] = {0.f, 0.f}, mk[2] = {0.f, 0.f};
              for (int t = gw; t < SEQ; t += NGW) { prep1_row(p, layer, t, lane); prep1_qknorm((const bf16*)(ws + WS_PROJ) + (size_t)t * NP1, lane, mq, mk); }
              if ((lane & 15) == 0) { const int g = lane >> 4;
                  atomicMax(&ctl[64 + layer * 16 + g * 2], __builtin_bit_cast(unsigned, mq[0])); atomicMax(&ctl[64 + layer * 16 + g * 2 + 1], __builtin_bit_cast(unsigned, mk[0]));
                  if (g < 2) { atomicMax(&ctl[64 + layer * 16 + (4 + g) * 2], __builtin_bit_cast(unsigned, mq[1])); atomicMax(&ctl[64 + layer * 16 + (4 + g) * 2 + 1], __builtin_bit_cast(unsigned, mk[1])); } } }
#endif
        } break;
        case 3: {
#ifndef NO_PREP1
            if (bx >= 192 && bx < 198) {
                const float* lf = (const float*)(ws + WS_LOGF) + (size_t)(bx - 192) * SEQ + tid * 32; float* cf = (float*)(ws + WS_CUMF) + (size_t)(bx - 192) * SEQ + tid * 32;
                f32x4 v[8]; double loc = 0.0;
#pragma unroll
                for (int j = 0; j < 8; ++j) { v[j] = ((const f32x4*)lf)[j]; loc += ((double)v[j].x + (double)v[j].y) + ((double)v[j].z + (double)v[j].w); }
                double inc = loc;
#pragma unroll
                for (int o = 1; o < 64; o <<= 1) { const double n = __shfl_up(inc, o); if (lane >= o) inc += n; }
                LAS double* wt = (LAS double*)(lds + 131072);
                if (lane == 63) wt[wave] = inc;
                __syncthreads();
                double off = inc - loc;
                for (int kk = 0; kk < wave; ++kk) off += wt[kk];
                __syncthreads();
#pragma unroll
                for (int j = 0; j < 8; ++j) { f32x4 o; off += (double)v[j].x; o.x = (float)off; off += (double)v[j].y; o.y = (float)off; off += (double)v[j].z; o.z = (float)off; off += (double)v[j].w; o.w = (float)off; ((f32x4*)cf)[j] = o; }
            }
#endif
            job0 = 2; njob = 2;
        } break;
        case 4: {
#ifndef NO_ATTN
            LAS volatile unsigned* word = (LAS volatile unsigned*)(lds + AT_WORD);
#ifdef PROBE_ATTN2
            for (int rep = 0; rep < 2; ++rep) { if (rep) grid.sync();
#else
            { const int rep = 0;
#endif
            for (;;) {
                if (tid == 0) *word = atomicAdd(&ctl[layer + 8 * rep], 1u);
                __syncthreads();
                const int idx = __builtin_amdgcn_readfirstlane((int)*word);
                __syncthreads();
                if (idx >= 1024) break;
                if (idx < 640) { const int qb = 63 - idx / 10, j = idx % 10;
#ifdef ONLY_MODE
                    if (ONLY_MODE == 0) self_attn_A(p, lds, layer, j & 3, qb); else if (ONLY_MODE == 2) self_attn_C(p, lds, layer, j % 6, qb); else self_attn_B(p, lds, layer, j % 6, qb); continue;
#endif
                    if (j < 4) self_attn_A(p, lds, layer, j, qb); else self_attn_C(p, lds, layer, j - 4, qb); }
                else { const int r = idx - 640; self_attn_B(p, lds, layer, r % 6, 63 - r / 6); }
            }
            }
#endif
        } break;
        case 5: job0 = 4; njob = 1; break;
        case 7: job0 = 5; njob = 1; break;
        case 8: {
#ifndef NO_XATTN
            for (int u = bx; u < 256; u += G) {
                const int h = u & 3, qb = u >> 2, q0 = qb * 256;
                f32x16 o[4];
                attn_pass<128, 3>(lds, (const bf16*)(ws + WS_QX) + h * 128, 512, (const bf16*)(ws + WS_KVX) + h * 128, 1024, nullptr, (const bf16*)(ws + WS_KVX) + 512 + h * 128, 1024, q0, 0, 4,
                                  0.08838834764831845f * LOG2E, nullptr, nullptr, nullptr, nullptr, nullptr, o);
                attn_finish(lds, o, false, 1.0f, nullptr, (bf16*)(ws + WS_OX), 512, q0, h * 128);
                __syncthreads();
            }
#endif
        } break;
        case 9: job0 = 6; njob = 1; break;
        case 11: job0 = 7; njob = 1; break;
        case 12: {
#ifndef NO_CONV
            for (int task = bx * 512 + tid; task < 512 * 512; task += G * 512) convgate_task(p, layer, task >> 9, task & 511);
#endif
        } break;
        default: job0 = 8; njob = 1; break;
        }
#ifndef NO_GEMM
#ifdef PROBE_GEMM2
        for (int jj2 = 0; jj2 < 2 * njob; ++jj2) { const int jj = jj2 % njob;
#else
        for (int jj = 0; jj < njob; ++jj) {
#endif
            const GemmJob J = gemm_job(ws, job0 + jj);
            pg8::Gemm g{J.A, J.Bt, J.M, J.N, J.K}; pg8::StaticOrder S; S.init(J.M, J.N, G, (bx + J.cshift) % G);
            if (J.f32) { pg8::EpiF32 E{(float*)J.C, J.ldc, nullptr}; pg8::gemm_phase<pg8::EpiF32, pg8::StaticOrder, true, true>(lds, g, S, E); }
            else { pg8::EpiBf16<0> E{(bf16*)J.C, J.ldc, nullptr, 0, 0, 1.f}; pg8::gemm_phase<pg8::EpiBf16<0>, pg8::StaticOrder, true, true>(lds, g, S, E); }
        }
#endif
        if (step == DEPTH * NSTEP) break;
        if (step == 0) { grid.sync(); (void)xcd_barrier_post(ctl + CW_BAR, (volatile LAS unsigned*)(lds + MISC_OFF)); }
        else { XcdBarrier b; b.bar = ctl + CW_BAR; b.x = xb_xcc_id(); b.st = (volatile LAS unsigned*)(lds + MISC_OFF); xcd_barrier(b); }
        { const Params* pq = pp0; asm volatile("" : "+s"(pq)); if (pq->stop_phase && step + 1 >= pq->stop_phase) return; }
    }
}

extern "C" void kernel_launch(void* const* d_in, const int* in_sizes, int n_in, void* d_out, int out_size, void* d_ws, size_t ws_size, hipStream_t stream) {
    static int grid = 0;
    if (grid == 0) {
        if (n_in != 22 || out_size != SEQ * DM || ws_size < WS_END) { fprintf(stderr, "kernel_launch: unexpected shapes (n_in %d, out %d, ws %zu < %zu)\n", n_in, out_size, ws_size, (size_t)WS_END); grid = -1; return; }
        int dev = 0, cus = 0, per_cu = 0;
        if (hipGetDevice(&dev) != hipSuccess || hipDeviceGetAttribute(&cus, hipDeviceAttributeMultiprocessorCount, dev) != hipSuccess) { fprintf(stderr, "kernel_launch: device query failed\n"); grid = -1; return; }
        if (hipFuncSetAttribute((const void*)mega_fwd, hipFuncAttributeMaxDynamicSharedMemorySize, LDS_BYTES) != hipSuccess) { fprintf(stderr, "kernel_launch: hipFuncSetAttribute failed\n"); grid = -1; return; }
        if (hipOccupancyMaxActiveBlocksPerMultiprocessor(&per_cu, (const void*)mega_fwd, 512, LDS_BYTES) != hipSuccess || per_cu < 1) { fprintf(stderr, "kernel_launch: occupancy query says %d blocks per CU\n", per_cu); (void)hipGetLastError(); per_cu = 1; }
        grid = cus * (per_cu > 1 ? 1 : per_cu);
        fprintf(stderr, "kernel_launch: grid %d (cus %d, per_cu %d)\n", grid, cus, per_cu);
    }
    if (grid < 0) return;
    Params p{};
    p.x = (const float*)d_in[0]; p.mem = (const float*)d_in[1]; p.pos = (const int*)d_in[2]; p.rel_bias = (const float*)d_in[3]; p.w_in = (const float*)d_in[4];
    p.b_forget = (const float*)d_in[5]; p.lam = (const float*)d_in[6]; p.q_norm = (const float*)d_in[7]; p.kv_norm = (const float*)d_in[8]; p.w_uq = (const float*)d_in[9];
    p.w_ukv = (const float*)d_in[10]; p.head_norm = (const float*)d_in[11]; p.w_out = (const float*)d_in[12]; p.norm_gains = (const float*)d_in[13]; p.mem_norm = (const float*)d_in[14];
    p.wq_x = (const float*)d_in[15]; p.wkv_x = (const float*)d_in[16]; p.wo_x = (const float*)d_in[17]; p.w_up = (const float*)d_in[18]; p.conv_w = (const float*)d_in[19];
    p.conv_b = (const float*)d_in[20]; p.w_down = (const float*)d_in[21];
    p.out = (float*)d_out; p.ws = (unsigned char*)d_ws;
    for (int i = 0; i < 4; ++i) p.lam_init[i] = (float)(0.8 - 0.6 * exp(-0.3 * i));
    p.stop_phase = 0; p.pad = 0;
    void* args[] = {&p};
    hipError_t e = hipLaunchCooperativeKernel((const void*)mega_fwd, dim3(grid), dim3(512), args, LDS_BYTES, stream);
    if (e != hipSuccess) fprintf(stderr, "kernel_launch: cooperative launch failed: %s (grid %d)\n", hipGetErrorString(e), grid);
}
```
